# Optimizing an MI355X kernel written in HIP

```python
import math
import jax, jax.numpy as jnp
from jax import lax
import numpy as np

D_MODEL = 1024
BATCH = 32
SEQ = 256
DEPTH = 4
DEC_BATCH = 4
DEC_SEQ = 1024
PAST_LEN = 512

GRID_W = 64
MIX_W = 512
HG_HEADS = 4
HG_DK = 128
HG_DV = MIX_W // HG_HEADS
HG_CHUNK = 16
ML_HEADS = 4
ML_DK = 128
ML_DV = MIX_W // ML_HEADS
ML_CHUNK = 64
MB_HEADS = 8
MB_HEADDIM = MIX_W // MB_HEADS
MB_DINNER = MIX_W
MB_GROUPS = 2
MB_DSTATE = 64
MB_CONV = 3
MB_XBC = MB_DINNER + 2 * MB_GROUPS * MB_DSTATE
MB_CHUNK = 64
D_FF = 2816
N_BRANCH = 3
N_MOD = 9
ALPHA = (2 * DEPTH) ** 0.25
BETA = (8 * DEPTH) ** -0.25
LN_EPS = 1e-5
RMS_EPS = 1e-6
IN_SIZES = (HG_HEADS * HG_DK, HG_HEADS * HG_DV, HG_HEADS * HG_DV, 2 * HG_HEADS * HG_DK,
            ML_HEADS * ML_DK, ML_HEADS * ML_DK, ML_HEADS * ML_DV, ML_HEADS * ML_DV, 2 * ML_HEADS, 2 * ML_HEADS,
            MB_DINNER, MB_XBC, 2 * MB_HEADS, N_BRANCH * D_MODEL)
D_IN = sum(IN_SIZES)

kernel_name = 'hybrid_diffusion_prefix_trunk'


def _split_points():
    pts, acc = [], 0
    for s in IN_SIZES[:-1]:
        acc += s
        pts.append(acc)
    return pts


def _causal(t):
    return jnp.tril(jnp.ones((t, t), dtype=bool))


def _layernorm(x, g, b):
    xf = x.astype(jnp.float32)
    mu = jnp.mean(xf, -1, keepdims=True)
    var = jnp.mean(jnp.square(xf - mu), -1, keepdims=True)
    return ((xf - mu) * lax.rsqrt(var + LN_EPS) * g + b).astype(x.dtype)


def _head_rms(x, g):
    xf = x.astype(jnp.float32)
    y = xf * lax.rsqrt(jnp.mean(xf * xf, -1, keepdims=True) + RMS_EPS)
    return y.reshape(x.shape[0], x.shape[1], -1) * g


def _modulate(x, shift, scale):
    return x * (1 + scale) + shift


def _swiglu(x, w_gu, w_down):
    a, b = jnp.split(jnp.einsum('bld,df->blf', x, w_gu), 2, axis=-1)
    return jnp.einsum('blf,fd->bld', jax.nn.silu(a) * b, w_down)


def _dwconv(x, w, b):
    out = lax.conv_general_dilated(x, w[:, None, :], window_strides=(1,), padding='SAME',
                                   dimension_numbers=('NWC', 'WIO', 'NWC'),
                                   feature_group_count=x.shape[-1])
    return out + b


def _state_scan(decay, contrib, s0):
    def step(s, dc):
        d, cn = dc
        return d * s + cn, s
    s_fin, s_in = lax.scan(step, s0, (jnp.moveaxis(decay, 1, 0), jnp.moveaxis(contrib, 1, 0)))
    return jnp.moveaxis(s_in, 0, 1), s_fin


def _bidir(scan_fn, args_f, args_b, state):
    y_f, s_f = scan_fn(*args_f, tuple(s[:, 0] for s in state))
    y_b, s_b = scan_fn(*(jnp.flip(a, 1) for a in args_b), tuple(s[:, 1] for s in state))
    return y_f + jnp.flip(y_b, 1), tuple(jnp.stack([a, b], axis=1) for a, b in zip(s_f, s_b))


def _hgrn2_scan(q, k, v, logf, state):
    (s0,) = state
    bsz, seq, h, dk = q.shape
    t = HG_CHUNK
    n = seq // t
    q, k, logf = [a.astype(jnp.float32).reshape(bsz, n, t, h, dk) for a in (q, k, logf)]
    v = v.astype(jnp.float32).reshape(bsz, n, t, h, HG_DV)
    b = jnp.cumsum(logf, axis=2)
    b_last = b[:, :, -1]
    e = b[:, :, :, None] - b[:, :, None, :]
    e = jnp.where(_causal(t)[:, :, None, None], e, -jnp.inf)
    att = jnp.einsum('bnthk,bnshk,bntshk->bntsh', q, k, jnp.exp(e))
    o = jnp.einsum('bntsh,bnshv->bnthv', att, v)
    contrib = jnp.einsum('bnshk,bnshv->bnhkv', k * jnp.exp(b_last[:, :, None] - b), v)
    s_in, s_fin = _state_scan(jnp.exp(b_last)[..., None], contrib, s0.astype(jnp.float32))
    o = o + jnp.einsum('bnthk,bnhkv->bnthv', q * jnp.exp(b), s_in)
    return o.reshape(bsz, seq, h, HG_DV), (s_fin,)


def _mlstm_scan(q, k, v, ig, logf, state):
    c0, n0, m0 = state
    bsz, seq, h, dk = q.shape
    t = ML_CHUNK
    n = seq // t
    q, k = [a.astype(jnp.float32).reshape(bsz, n, t, h, dk) for a in (q, k)]
    v = v.astype(jnp.float32).reshape(bsz, n, t, h, ML_DV)
    ig, logf = [a.astype(jnp.float32).reshape(bsz, n, t, h) for a in (ig, logf)]
    b = jnp.cumsum(logf, axis=2)
    b_last = b[:, :, -1]
    g = b_last[:, :, None] - b + ig
    g_max = jnp.max(g, axis=2)
    wg = jnp.exp(g - g_max[:, :, None])
    c_loc = jnp.einsum('bnsh,bnshk,bnshv->bnhkv', wg, k, v)
    n_loc = jnp.einsum('bnsh,bnshk->bnhk', wg, k)

    def step(carry, inp):
        cm, nm, mm = carry
        bl, gm, cl, nl = inp
        m_new = jnp.maximum(bl + mm, gm)
        a = jnp.exp(bl + mm - m_new)
        s = jnp.exp(gm - m_new)
        return (a[..., None, None] * cm + s[..., None, None] * cl, a[..., None] * nm + s[..., None] * nl, m_new), (cm, nm, mm)

    xs = tuple(jnp.moveaxis(a, 1, 0) for a in (b_last, g_max, c_loc, n_loc))
    init = (c0.astype(jnp.float32), n0.astype(jnp.float32), m0.astype(jnp.float32))
    (c_f, n_f, m_f), (c_in, n_in, m_in) = lax.scan(step, init, xs)
    c_in, n_in, m_in = [jnp.moveaxis(a, 0, 1) for a in (c_in, n_in, m_in)]
    bt = jnp.swapaxes(b, 2, 3)
    it = jnp.swapaxes(ig, 2, 3)
    dlog = jnp.where(_causal(t), bt[..., :, None] - bt[..., None, :] + it[..., None, :], -jnp.inf)
    m_inter = bt + m_in[..., None]
    m_t = jnp.maximum(m_inter, jnp.max(dlog, -1))
    s = jnp.exp(dlog - m_t[..., None]) * jnp.einsum('bnthk,bnshk->bnhts', q, k)
    w_inter = jnp.exp(m_inter - m_t)
    num = (jnp.einsum('bnhts,bnshv->bnthv', s, v)
           + jnp.swapaxes(w_inter, 2, 3)[..., None] * jnp.einsum('bnthk,bnhkv->bnthv', q, c_in))
    den = jnp.sum(s, -1) + w_inter * jnp.einsum('bnthk,bnhk->bnht', q, n_in)
    den = jnp.maximum(jnp.abs(den), jnp.exp(-m_t))
    hout = num / jnp.swapaxes(den, 2, 3)[..., None]
    return hout.reshape(bsz, seq, h, ML_DV), (c_f, n_f, m_f)


def _ssd_scan(x, dt, la, bm, cm, state):
    (h0,) = state
    bsz, seq, h, p = x.shape
    t = MB_CHUNK
    n = seq // t
    x = x.astype(jnp.float32).reshape(bsz, n, t, h, p)
    dt = dt.reshape(bsz, n, t, h)
    bm = bm.astype(jnp.float32).reshape(bsz, n, t, h, MB_DSTATE)
    cm = cm.astype(jnp.float32).reshape(bsz, n, t, h, MB_DSTATE)
    a = jnp.cumsum(la.reshape(bsz, n, t, h), axis=2)
    a_last = a[:, :, -1]
    at = jnp.swapaxes(a, 2, 3)
    seg = jnp.where(_causal(t), at[..., :, None] - at[..., None, :], -jnp.inf)
    xdt = x * dt[..., None]
    cb = jnp.einsum('bnthd,bnshd->bnhts', cm, bm)
    y = jnp.einsum('bnhts,bnshp->bnthp', jnp.exp(seg) * cb, xdt)
    contrib = jnp.einsum('bnshd,bnshp->bnhpd', bm * jnp.exp(a_last[:, :, None] - a)[..., None], xdt)
    h_in, h_fin = _state_scan(jnp.exp(a_last)[..., None, None], contrib, h0.astype(jnp.float32))
    y = y + jnp.einsum('bnthd,bnhpd->bnthp', cm * jnp.exp(a)[..., None], h_in)
    return y.reshape(bsz, seq, h, p), (h_fin,)


def _token_mixer(hin, p, states):
    bsz, seq = hin.shape[0], hin.shape[1]
    u = jnp.einsum('bld,de->ble', hin, p['w_in'])
    (hq, hi, hg, hf, mq, mk, mv, mo, mi, mf, mz, mxbc, mdt, bg) = jnp.split(u, _split_points(), axis=-1)
    hg_s, ml_c, ml_n, ml_m, mb_s = states

    lb = p['hg_lb']
    q = jax.nn.silu(hq).reshape(bsz, seq, HG_HEADS, HG_DK)
    iv = hi.reshape(bsz, seq, HG_HEADS, HG_DV)
    fpre = hf.astype(jnp.float32).reshape(bsz, seq, 2, HG_HEADS, HG_DK)
    logf = jnp.logaddexp(jnp.log(lb), jnp.log1p(-lb) + jax.nn.log_sigmoid(fpre))
    kk = (1.0 - lb) * jax.nn.sigmoid(-fpre)
    o_hg, hg_new = _bidir(_hgrn2_scan, (q, kk[:, :, 0], iv, logf[:, :, 0]),
                          (q, kk[:, :, 1], iv, logf[:, :, 1]), (hg_s,))
    y_hg = _head_rms(o_hg, p['hg_norm_g']) * jax.nn.silu(hg.astype(jnp.float32))

    qm = mq.reshape(bsz, seq, ML_HEADS, ML_DK)
    km = mk.reshape(bsz, seq, ML_HEADS, ML_DK) * (ML_DK ** -0.5)
    vm = mv.reshape(bsz, seq, ML_HEADS, ML_DV)
    gb = p['ml_gate_b']
    ig = mi.astype(jnp.float32).reshape(bsz, seq, 2, ML_HEADS) + gb[0]
    lf = jax.nn.log_sigmoid(mf.astype(jnp.float32).reshape(bsz, seq, 2, ML_HEADS) + gb[1])
    h_ml, ml_new = _bidir(_mlstm_scan, (qm, km, vm, ig[:, :, 0], lf[:, :, 0]),
                          (qm, km, vm, ig[:, :, 1], lf[:, :, 1]), (ml_c, ml_n, ml_m))
    y_ml = _head_rms(h_ml, p['ml_norm_g']) * jax.nn.sigmoid(mo.astype(jnp.float32))

    xbc = jax.nn.silu(_dwconv(mxbc, p['mb_conv_w'], p['mb_conv_b']))
    mx, mb_b, mb_c = jnp.split(xbc, [MB_DINNER, MB_DINNER + MB_GROUPS * MB_DSTATE], axis=-1)
    mx = mx.reshape(bsz, seq, MB_HEADS, MB_HEADDIM)
    rep = MB_HEADS // MB_GROUPS
    mb_b = jnp.repeat(mb_b.reshape(bsz, seq, MB_GROUPS, MB_DSTATE), rep, axis=2)
    mb_c = jnp.repeat(mb_c.reshape(bsz, seq, MB_GROUPS, MB_DSTATE), rep, axis=2)
    dt = jax.nn.softplus(mdt.astype(jnp.float32).reshape(bsz, seq, 2, MB_HEADS) + p['mb_dt_bias'])
    la = dt * -jnp.exp(p['mb_a_log'].astype(jnp.float32))
    y_mb, mb_new = _bidir(_ssd_scan, (mx, dt[:, :, 0], la[:, :, 0], mb_b, mb_c),
                          (mx, dt[:, :, 1], la[:, :, 1], mb_b, mb_c), (mb_s,))
    y_mb = y_mb + p['mb_d'][:, None] * mx
    y_mb = _head_rms((y_mb.reshape(bsz, seq, MB_DINNER) * jax.nn.silu(mz.astype(jnp.float32)))[:, :, None], p['mb_norm_g'])

    br = jnp.stack([y_hg, y_ml, y_mb], axis=2).astype(hin.dtype)
    proj = jnp.einsum('blcr,crd->blcd', br, p['w_branch'])
    gates = jax.nn.sigmoid(bg.reshape(bsz, seq, N_BRANCH, D_MODEL))
    y = jnp.einsum('blcd,de->ble', gates * proj, p['w_out'])
    return y, (hg_new[0], ml_new[0], ml_new[1], ml_new[2], mb_new[0])


def _layer(x, mod, p, states):
    sh1, sc1, g1, sh2, sc2, g2, sh3, sc3, g3 = jnp.split(mod, N_MOD, axis=-1)
    x = _layernorm(ALPHA * x + 0.5 * g1 * _swiglu(_modulate(x, sh1, sc1), p['ffn_w_gu'][0], p['ffn_w_down'][0]),
                   p['ln_g'][0], p['ln_b'][0])
    y, new_states = _token_mixer(_modulate(x, sh2, sc2), p, states)
    x = _layernorm(ALPHA * x + g2 * y, p['ln_g'][1], p['ln_b'][1])
    x = _layernorm(ALPHA * x + 0.5 * g3 * _swiglu(_modulate(x, sh3, sc3), p['ffn_w_gu'][1], p['ffn_w_down'][1]),
                   p['ln_g'][2], p['ln_b'][2])
    return x, new_states


def _grid_pos_embed(n_tok):
    rows = n_tok // GRID_W
    r, cidx = jnp.meshgrid(jnp.arange(rows, dtype=jnp.float32), jnp.arange(GRID_W, dtype=jnp.float32), indexing='ij')
    quarter = D_MODEL // 4
    freq = jnp.exp(-math.log(10000.0) * jnp.arange(quarter, dtype=jnp.float32) / quarter)
    ar = r.reshape(-1, 1) * freq
    ac = cidx.reshape(-1, 1) * freq
    return jnp.concatenate([jnp.sin(ar), jnp.cos(ar), jnp.sin(ac), jnp.cos(ac)], axis=-1)


def _zero_states(bsz):
    z = lambda *s: jnp.zeros((bsz, 2) + s, jnp.float32)
    return (z(HG_HEADS, HG_DK, HG_DV), z(ML_HEADS, ML_DK, ML_DV), z(ML_HEADS, ML_DK), z(ML_HEADS),
            z(MB_HEADS, MB_HEADDIM, MB_DSTATE))


def setup_inputs(seed: int = 0) -> dict:
    key = jax.random.key(seed)
    ks = iter(jax.random.split(key, 40))
    nrm = lambda shape, s=1.0: s * jax.random.normal(next(ks), shape, jnp.float32)
    unif = lambda shape, lo, hi: jax.random.uniform(next(ks), shape, jnp.float32, lo, hi)
    d = D_MODEL
    st = (DEC_BATCH, DEPTH, 2)
    dt0 = jnp.exp(unif((DEPTH, 2, MB_HEADS), math.log(1e-3), math.log(1e-1)))
    return {
        'x_prompt': nrm((BATCH, SEQ, d)),
        'x_sample': nrm((DEC_BATCH, DEC_SEQ, d)),
        'state_hgrn': nrm(st + (HG_HEADS, HG_DK, HG_DV), 0.5),
        'state_mlstm_C': nrm(st + (ML_HEADS, ML_DK, ML_DV), 0.3),
        'state_mlstm_n': nrm(st + (ML_HEADS, ML_DK), 0.3),
        'state_mlstm_m': nrm(st + (ML_HEADS,), 1.0),
        'state_ssd': nrm(st + (MB_HEADS, MB_HEADDIM, MB_DSTATE), 0.5),
        'c': nrm((DEC_BATCH, d)),
        'c_ctx': nrm((d,)),
        'w_mod': nrm((DEPTH, d, N_MOD * d), 0.5 * d ** -0.5),
        'b_mod': nrm((DEPTH, N_MOD * d), 0.02),
        'ln_g': 1.0 + nrm((DEPTH, 3, d), 0.02),
        'ln_b': nrm((DEPTH, 3, d), 0.02),
        'ffn_w_gu': nrm((DEPTH, 2, d, 2 * D_FF), d ** -0.5),
        'ffn_w_down': nrm((DEPTH, 2, D_FF, d), BETA * D_FF ** -0.5),
        'w_in': nrm((DEPTH, d, D_IN), d ** -0.5),
        'hg_lb': nrm((DEPTH, 2, HG_HEADS * HG_DK)),
        'hg_norm_g': 1.0 + nrm((DEPTH, HG_HEADS * HG_DV), 0.02),
        'ml_gate_b': jnp.stack([nrm((DEPTH, 2, ML_HEADS), 0.1), unif((DEPTH, 2, ML_HEADS), 3.0, 6.0)], axis=1),
        'ml_norm_g': 1.0 + nrm((DEPTH, ML_HEADS * ML_DV), 0.02),
        'mb_conv_w': nrm((DEPTH, MB_CONV, MB_XBC), MB_CONV ** -0.5),
        'mb_conv_b': nrm((DEPTH, MB_XBC), 0.02),
        'mb_dt_bias': dt0 + jnp.log(-jnp.expm1(-dt0)),
        'mb_a_log': jnp.log(unif((DEPTH, 2, MB_HEADS), 1.0, 16.0)),
        'mb_d': 1.0 + nrm((DEPTH, MB_HEADS), 0.02),
        'mb_norm_g': 1.0 + nrm((DEPTH, MB_DINNER), 0.02),
        'w_branch': nrm((DEPTH, N_BRANCH, MIX_W, d), MIX_W ** -0.5),
        'w_out': nrm((DEPTH, d, d), BETA * d ** -0.5),
    }


def reference(x_prompt, x_sample, state_hgrn, state_mlstm_C, state_mlstm_n, state_mlstm_m, state_ssd, c, c_ctx,
              w_mod, b_mod, ln_g, ln_b, ffn_w_gu, ffn_w_down, w_in, hg_lb, hg_norm_g, ml_gate_b, ml_norm_g,
              mb_conv_w, mb_conv_b, mb_dt_bias, mb_a_log, mb_d, mb_norm_g, w_branch, w_out):
    lbs = jnp.cumsum(jax.nn.softmax(hg_lb.astype(jnp.float32), axis=0), axis=0)
    lbs = (lbs - lbs[0]).reshape(DEPTH, 2, HG_HEADS, HG_DK)
    params = [{'w_in': w_in[l], 'hg_lb': lbs[l], 'hg_norm_g': hg_norm_g[l], 'ml_gate_b': ml_gate_b[l],
               'ml_norm_g': ml_norm_g[l], 'mb_conv_w': mb_conv_w[l], 'mb_conv_b': mb_conv_b[l],
               'mb_dt_bias': mb_dt_bias[l], 'mb_a_log': mb_a_log[l], 'mb_d': mb_d[l], 'mb_norm_g': mb_norm_g[l],
               'w_branch': w_branch[l], 'w_out': w_out[l], 'ln_g': ln_g[l], 'ln_b': ln_b[l],
               'ffn_w_gu': ffn_w_gu[l], 'ffn_w_down': ffn_w_down[l]} for l in range(DEPTH)]
    mod_ctx = jnp.einsum('d,lde->le', jax.nn.silu(c_ctx), w_mod) + b_mod
    mod_lat = jnp.einsum('bd,lde->lbe', jax.nn.silu(c), w_mod) + b_mod[:, None]

    xc = x_prompt
    collected = ([], [], [], [], [])
    for l in range(DEPTH):
        xc, st = _layer(xc, mod_ctx[l][None, None], params[l], _zero_states(x_prompt.shape[0]))
        for lst, s in zip(collected, st):
            lst.append(s)
    y_prompt = xc
    new_state_hgrn = jnp.stack(collected[0], axis=1)
    new_state_mlstm_C = jnp.stack(collected[1], axis=1)
    new_state_mlstm_n = jnp.stack(collected[2], axis=1)
    new_state_mlstm_m = jnp.stack(collected[3], axis=1)
    new_state_ssd = jnp.stack(collected[4], axis=1)

    xs = x_sample + _grid_pos_embed(x_sample.shape[1]).astype(x_sample.dtype)[None]
    for l in range(DEPTH):
        st = (state_hgrn[:, l], state_mlstm_C[:, l], state_mlstm_n[:, l], state_mlstm_m[:, l], state_ssd[:, l])
        xs, _ = _layer(xs, mod_lat[l][:, None], params[l], st)
    y_sample = xs
    return (y_prompt, y_sample, new_state_hgrn, new_state_mlstm_C, new_state_mlstm_n, new_state_mlstm_m, new_state_ssd)
```

```cpp
#include <hip/hip_runtime.h>
#include <hip/hip_cooperative_groups.h>
#include <cstdio>
namespace cg = cooperative_groups;

typedef __attribute__((ext_vector_type(8))) short bf16x8;
typedef __attribute__((ext_vector_type(4))) float f32x4;
typedef unsigned short u16;

constexpr int D = 1024, TCTX = 8192, TT = 12288, DFF = 2816, DIN = 8992, DINP = 9216;
constexpr int HQ = 0, HI = 512, HGO = 1024, HF = 1536, MQ = 2560, MK = 3072, MV = 3584, MO = 4096, MI = 4608, MF = 4616,
              MZ = 4624, MXBC = 5136, MDT = 5904, BG = 5920;
constexpr float ALPHA = 1.681792830507429f;
constexpr int NTHR = 512, NW = 8;
constexpr int LDS_BYTES = 163840;

constexpr size_t OFF_CTR = 0;
constexpr size_t OFF_BAR = 256;
constexpr size_t OFF_LNCNT = 16384;
constexpr size_t CTL_BYTES = 32768;
constexpr size_t OFF_XBUF = CTL_BYTES;
constexpr size_t OFF_WGU = OFF_XBUF + (size_t)TT * 4 * 8;
constexpr size_t OFF_WDN = OFF_WGU + (size_t)2 * 5632 * 1024 * 2;
constexpr size_t OFF_WIN = OFF_WDN + (size_t)2 * 1024 * 2816 * 2;
constexpr size_t OFF_WBR = OFF_WIN + (size_t)DINP * 1024 * 2;
constexpr size_t OFF_WOUT = OFF_WBR + (size_t)3 * 1024 * 512 * 2;
constexpr size_t WSET = OFF_WOUT + (size_t)1024 * 1024 * 2 - OFF_WGU;
constexpr size_t OFF_MOD = OFF_WGU + 2 * WSET;
constexpr size_t OFF_LBS = OFF_MOD + (size_t)4 * 5 * 9216 * 4;
constexpr size_t OFF_X = OFF_LBS + (size_t)4 * 2 * 512 * 4;
constexpr size_t OFF_Z = OFF_X + (size_t)TT * D * 4;
constexpr size_t OFF_XM = OFF_Z + (size_t)TT * D * 4;
constexpr size_t OFF_U = OFF_XM + (size_t)TT * D * 2;
constexpr size_t OFF_O = OFF_U + (size_t)TT * DINP * 2;
constexpr size_t OFF_Y = OFF_O + (size_t)6 * TT * 512 * 2;
constexpr size_t OFF_G = OFF_Y + (size_t)TT * 1536 * 2;
constexpr size_t WS_END = OFF_G + (size_t)TT * 1024 * 2;

struct Params {
    const float* in[28];
    float* out;
    unsigned char* ws;
};

__device__ __forceinline__ unsigned pack2(float a, float b) {
    unsigned r;
    asm("v_cvt_pk_bf16_f32 %0, %1, %2" : "=v"(r) : "v"(a), "v"(b));
    return r;
}
__device__ __forceinline__ u16 f2bf(float f) { return (u16)(pack2(f, 0.f) & 0xffffu); }
__device__ __forceinline__ float bf2f(u16 h) { return __uint_as_float(((unsigned)h) << 16); }
__device__ __forceinline__ float sigm(float x) { return 1.f / (1.f + __expf(-x)); }
__device__ __forceinline__ float silu(float x) { return x / (1.f + __expf(-x)); }

__device__ __forceinline__ u16 get16(const uint4& v, int e) {
    const unsigned wv = (e >> 1) == 0 ? v.x : (e >> 1) == 1 ? v.y : (e >> 1) == 2 ? v.z : v.w;
    return (u16)((e & 1) ? (wv >> 16) : (wv & 0xffffu));
}
__device__ __forceinline__ int fresh_bid() {
    int b = blockIdx.x;
    asm volatile("" : "+s"(b));
    return b;
}
__device__ __forceinline__ int fresh_tid() {
    int t = threadIdx.x;
    asm volatile("" : "+v"(t));
    return t;
}

template <int MT, int NT, bool SWA = false, bool SWB = false>
__device__ __forceinline__ void mma_nt(f32x4 (&acc)[MT][NT], const u16* A, int lda, const u16* B, int ldb, int K, int lane, int arow0 = 0, int brow0 = 0) {
    const int lr = lane & 15, lq = lane >> 4;
    for (int k0 = 0; k0 < K; k0 += 32) {
        bf16x8 a[MT], b[NT];
#pragma unroll
        for (int m = 0; m < MT; ++m) {
            const int ch = SWA ? ((((k0 >> 3) + lq) ^ (((arow0 + m * 16 + lr) >> 3) & 7)) << 3) : (k0 + lq * 8);
            a[m] = *(const bf16x8*)(A + (m * 16 + lr) * lda + ch);
        }
#pragma unroll
        for (int n = 0; n < NT; ++n) {
            const int ch = SWB ? ((((k0 >> 3) + lq) ^ (((brow0 + n * 16 + lr) >> 3) & 7)) << 3) : (k0 + lq * 8);
            b[n] = *(const bf16x8*)(B + (n * 16 + lr) * ldb + ch);
        }
#pragma unroll
        for (int m = 0; m < MT; ++m)
#pragma unroll
            for (int n = 0; n < NT; ++n) acc[m][n] = __builtin_amdgcn_mfma_f32_16x16x32_bf16(a[m], b[n], acc[m][n], 0, 0, 0);
    }
}

__device__ __forceinline__ int modset_of_row(int row) { return row < TCTX ? 0 : 1 + ((row - TCTX) >> 10); }

__device__ __forceinline__ void convert_tile(const Params& p, int l, int it, unsigned char* smem) {
    float* sm = (float*)smem;
    const int tid = fresh_tid();
    const size_t wb = (size_t)(l & 1) * WSET;
    u16* WGU = (u16*)(p.ws + OFF_WGU + wb);
    u16* WDN = (u16*)(p.ws + OFF_WDN + wb);
    u16* WIN = (u16*)(p.ws + OFF_WIN + wb);
    u16* WBR = (u16*)(p.ws + OFF_WBR + wb);
    u16* WOUT = (u16*)(p.ws + OFF_WOUT + wb);
    {
        const float* src;
        u16* dst;
        int K, N, tn, mode = 0, t = it;
        if (t < 704) {
            int i = t / 352; t -= i * 352;
            src = p.in[13] + ((size_t)(l * 2 + i)) * 1024 * 5632; dst = WGU + (size_t)i * 5632 * 1024; K = 1024; N = 5632; tn = 22; mode = 1;
        } else if (t < 704 + 352) {
            t -= 704; int i = t / 176; t -= i * 176;
            src = p.in[14] + ((size_t)(l * 2 + i)) * 2816 * 1024; dst = WDN + (size_t)i * 1024 * 2816; K = 2816; N = 1024; tn = 4;
        } else if (t < 1056 + 576) {
            t -= 1056;
            src = p.in[15] + (size_t)l * 1024 * DIN; dst = WIN; K = 1024; N = DIN; tn = 36;
        } else if (t < 1632 + 96) {
            t -= 1632; int c = t / 32; t -= c * 32;
            src = p.in[26] + ((size_t)(l * 3 + c)) * 512 * 1024; dst = WBR + (size_t)c * 1024 * 512; K = 512; N = 1024; tn = 4;
        } else {
            t -= 1728;
            src = p.in[27] + (size_t)l * 1024 * 1024; dst = WOUT; K = 1024; N = 1024; tn = 4;
        }
        const int kt = t / tn, ntl = t - kt * tn;
        const int k0 = kt * 64, n0 = ntl * 256;
        float4 v[8];
#pragma unroll
        for (int ps = 0; ps < 8; ++ps) {
            const int kr = ps * 8 + (tid >> 6), c4 = (tid & 63) * 4;
            v[ps] = make_float4(0.f, 0.f, 0.f, 0.f);
            if (n0 + c4 < N) v[ps] = *(const float4*)(src + (size_t)(k0 + kr) * N + n0 + c4);
        }
#pragma unroll
        for (int ps = 0; ps < 8; ++ps) {
            const int kr = ps * 8 + (tid >> 6), c4 = (tid & 63) * 4;
            sm[kr * 257 + c4 + 0] = v[ps].x; sm[kr * 257 + c4 + 1] = v[ps].y; sm[kr * 257 + c4 + 2] = v[ps].z; sm[kr * 257 + c4 + 3] = v[ps].w;
        }
        __syncthreads();
        {
            const int nl = tid >> 1, ks = (tid & 1) * 32;
            int n = n0 + nl, nd = n;
            if (mode == 1) {
                int part = n >= 2816 ? 1 : 0;
                int nn = n - part * 2816;
                nd = (nn >> 7) * 256 + part * 128 + (nn & 127);
            }
            u16* dp = dst + (size_t)nd * K + k0 + ks;
#pragma unroll
            for (int q = 0; q < 4; ++q) {
                unsigned pk[4];
#pragma unroll
                for (int j = 0; j < 4; ++j) pk[j] = pack2(sm[(ks + q * 8 + 2 * j) * 257 + nl], sm[(ks + q * 8 + 2 * j + 1) * 257 + nl]);
                *(uint4*)(dp + q * 8) = make_uint4(pk[0], pk[1], pk[2], pk[3]);
            }
        }
        __syncthreads();
    }
}

constexpr int CONV_TILES = (1408 * 2 + 704 * 2 + 2304 + 128 * 3 + 256) / 4;
__device__ __forceinline__ void convert_layer(const Params& p, int l, unsigned char* smem) {
    for (int it = fresh_bid(); it < CONV_TILES; it += gridDim.x) convert_tile(p, l, it, smem);
}

__device__ __forceinline__ void phase_mod(const Params& p, unsigned char* smem) {
    float* sc = (float*)smem;
    float* red = sc + 5 * 1024;
    const int tid = fresh_tid();
    for (int i = tid; i < 5 * 1024; i += NTHR) {
        int j = i >> 10, d = i & 1023;
        float v = (j == 0) ? p.in[8][d] : p.in[7][(j - 1) * 1024 + d];
        sc[i] = silu(v);
    }
    __syncthreads();
    float* MOD = (float*)(p.ws + OFF_MOD);
    const int col = tid & 63, q = tid >> 6;
    for (int it = fresh_bid(); it < 4 * 144; it += gridDim.x) {
        const int l = it / 144, e = (it % 144) * 64 + col;
        const float* wp = p.in[9] + (size_t)l * 1024 * 9216 + e;
        float a0 = 0, a1 = 0, a2 = 0, a3 = 0, a4 = 0;
#pragma unroll 32
        for (int d = q * 128; d < q * 128 + 128; ++d) {
            float wv = wp[(size_t)d * 9216];
            a0 += sc[d] * wv; a1 += sc[1024 + d] * wv; a2 += sc[2048 + d] * wv; a3 += sc[3072 + d] * wv; a4 += sc[4096 + d] * wv;
        }
        red[(q * 5 + 0) * 64 + col] = a0; red[(q * 5 + 1) * 64 + col] = a1; red[(q * 5 + 2) * 64 + col] = a2;
        red[(q * 5 + 3) * 64 + col] = a3; red[(q * 5 + 4) * 64 + col] = a4;
        __syncthreads();
        for (int i = tid; i < 5 * 64; i += NTHR) {
            int j = i >> 6, cc = i & 63;
            float s = 0.f;
            for (int qq = 0; qq < 8; ++qq) s += red[(qq * 5 + j) * 64 + cc];
            int ee = (it % 144) * 64 + cc;
            MOD[((size_t)l * 5 + j) * 9216 + ee] = s + p.in[10][l * 9216 + ee];
        }
        __syncthreads();
    }
    float* LBS = (float*)(p.ws + OFF_LBS);
    for (int i = fresh_bid() * NTHR + tid; i < 1024; i += gridDim.x * NTHR) {
        float v0 = p.in[16][i], v1 = p.in[16][1024 + i], v2 = p.in[16][2048 + i], v3 = p.in[16][3072 + i];
        float mx = fmaxf(fmaxf(v0, v1), fmaxf(v2, v3));
        float e0 = expf(v0 - mx), e1 = expf(v1 - mx), e2 = expf(v2 - mx), e3 = expf(v3 - mx);
        float inv = 1.f / (e0 + e1 + e2 + e3);
        LBS[i] = 0.f; LBS[1024 + i] = e1 * inv; LBS[2048 + i] = (e1 + e2) * inv; LBS[3072 + i] = (e1 + e2 + e3) * inv;
    }
}

__device__ __forceinline__ void phase_xinit(const Params& p) {
    u16* X = (u16*)(p.ws + OFF_X);
    u16* XM = (u16*)(p.ws + OFF_XM);
    const float* MOD = (const float*)(p.ws + OFF_MOD);
    const int tid = fresh_tid();
    for (size_t i4 = (size_t)fresh_bid() * NTHR + tid; i4 < (size_t)TT * D / 4; i4 += (size_t)gridDim.x * NTHR) {
        const int row = (int)(i4 >> 8), c0 = (int)(i4 & 255) * 4;
        float v[4];
        if (row < TCTX) {
            float4 t = *(const float4*)(p.in[0] + (size_t)row * D + c0);
            v[0] = t.x; v[1] = t.y; v[2] = t.z; v[3] = t.w;
        } else {
            float4 t = *(const float4*)(p.in[1] + (size_t)(row - TCTX) * D + c0);
            v[0] = t.x; v[1] = t.y; v[2] = t.z; v[3] = t.w;
            const int tk = (row - TCTX) & 1023;
            const float rr = (float)(tk >> 6), cc = (float)(tk & 63);
#pragma unroll
            for (int j = 0; j < 4; ++j) {
                int d = c0 + j, qd = d >> 8, fi = d & 255;
                float freq = expf(-9.210340371976184f * (float)fi / 256.f);
                float ang = ((qd < 2) ? rr : cc) * freq;
                v[j] += (qd & 1) ? cosf(ang) : sinf(ang);
            }
        }
        *(uint2*)(X + (size_t)row * D + c0) = make_uint2(pack2(v[0], v[1]), pack2(v[2], v[3]));
        const float* md = MOD + (size_t)(0 * 5 + modset_of_row(row)) * 9216;
        float m[4];
#pragma unroll
        for (int j = 0; j < 4; ++j) m[j] = v[j] * (1.f + md[1024 + c0 + j]) + md[c0 + j];
        *(uint2*)(XM + (size_t)row * D + c0) = make_uint2(pack2(m[0], m[1]), pack2(m[2], m[3]));
    }
}

__device__ __forceinline__ Params fresh(const Params& p0) {
#if defined(__HIP_DEVICE_COMPILE__)
    typedef const __attribute__((address_space(4))) Params* KP;
    KP kp = (KP)__builtin_amdgcn_kernarg_segment_ptr();
    asm volatile("" : "+s"(kp));
    Params q;
#pragma unroll
    for (int i = 0; i < 28; ++i) q.in[i] = kp->in[i];
    q.out = kp->out; q.ws = kp->ws;
    return q;
#else
    return p0;
#endif
}
#define XB_TMO      128
#define XB_XCNT(j)  (256  + 64 * (j))
#define XB_XSUB(j)  (1280 + 64 * (j))
#define XB_XGEN(j)  (2304 + 64 * (j))
#define XB_TOP      3328
#define XB_TOPGEN   3392
#define XCD_BAR_WORDS 3456
#define XB_SPIN_CAP (1u << 18)
#define LAS __attribute__((address_space(3)))
__device__ __forceinline__ unsigned xb_ld(unsigned* p)              { return __hip_atomic_load(p, __ATOMIC_RELAXED, __HIP_MEMORY_SCOPE_AGENT); }
__device__ __forceinline__ unsigned xb_add(unsigned* p, unsigned v) { return __hip_atomic_fetch_add(p, v, __ATOMIC_RELAXED, __HIP_MEMORY_SCOPE_AGENT); }
__device__ __forceinline__ unsigned xb_xcc_id() { return (unsigned)__builtin_amdgcn_s_getreg((3 << 11) | 20) & 0xFu; }
#define XB_SPIN(cond, bar) do { unsigned _sp = 0; while (cond) { __builtin_amdgcn_s_sleep(1); \
    if ((++_sp & 255u) == 0u) { if (xb_ld(&(bar)[XB_TMO])) break; if (_sp > XB_SPIN_CAP) { atomicAdd(&(bar)[XB_TMO], 1u); break; } } } } while (0)
struct XcdBarrier { unsigned* bar; unsigned x; volatile LAS unsigned* st; };
__device__ __forceinline__ XcdBarrier xcd_barrier_post(unsigned* bar, volatile LAS unsigned* st) {
    XcdBarrier b; b.bar = bar; b.x = xb_xcc_id(); b.st = st;
    if (threadIdx.x == 0) (void)xb_add(&bar[XB_XCNT(b.x)], 1u);
    return b;
}
__device__ __forceinline__ void xcd_barrier_complete(unsigned* bar, unsigned x, unsigned& nloc, unsigned& nx) {
    const unsigned G = gridDim.x * gridDim.y * gridDim.z;
    unsigned sum, cnt, mine, sp = 0u;
    for (;;) {
        sum = 0u; cnt = 0u; mine = 0u;
#pragma unroll
        for (unsigned j = 0; j < 16; ++j) { const unsigned c = xb_ld(&bar[XB_XCNT(j)]); sum += c; cnt += (c > 0u) ? 1u : 0u; mine = (j == x) ? c : mine; }
        if (sum == G) break;
        __builtin_amdgcn_s_sleep(1);
        if ((++sp & 255u) == 0u) { if (xb_ld(&bar[XB_TMO])) break; if (sp > XB_SPIN_CAP) { atomicAdd(&bar[XB_TMO], 1u); break; } }
    }
    nloc = mine > 0u ? mine : 1u; nx = cnt > 0u ? cnt : 1u;
}
__device__ __forceinline__ void xcd_barrier_(const XcdBarrier& b) {
    asm volatile("s_waitcnt vmcnt(0)" ::: "memory");
    __syncthreads();
    if (fresh_tid() == 0) {
        unsigned* bar = b.bar;
        __builtin_amdgcn_s_waitcnt(0);
        unsigned nloc = b.st[0], nx = b.st[1];
        if (nloc == 0u) { xcd_barrier_complete(bar, b.x, nloc, nx); b.st[0] = nloc; b.st[1] = nx; }
        const unsigned old = xb_add(&bar[XB_XSUB(b.x)], 1u);
        const unsigned gen = old / nloc;
        if (old + 1u == (gen + 1u) * nloc) {
            __builtin_amdgcn_fence(__ATOMIC_RELEASE, "agent");
            asm volatile("s_waitcnt vmcnt(0)" ::: "memory");
            const unsigned og = xb_add(&bar[XB_TOP], 1u);
            const unsigned tg = og / nx;
            if (og + 1u == (tg + 1u) * nx) xb_add(&bar[XB_TOPGEN], 1u);
            else XB_SPIN(xb_ld(&bar[XB_TOPGEN]) == tg, bar);
            __builtin_amdgcn_fence(__ATOMIC_ACQUIRE, "agent");
            xb_add(&bar[XB_XGEN(b.x)], 1u);
            asm volatile("s_waitcnt vmcnt(0)" ::: "memory");
        } else {
            XB_SPIN(xb_ld(&bar[XB_XGEN(b.x)]) == gen, bar);
            __builtin_amdgcn_fence(__ATOMIC_ACQUIRE, "agent");
            asm volatile("s_waitcnt vmcnt(0)" ::: "memory");
        }
    }
    __syncthreads();
}

__device__ __forceinline__ void xcd_barrier(const Params& p0, unsigned char* smem) {
    Params q = fresh(p0);
    XcdBarrier b; b.bar = (unsigned*)(q.ws + OFF_BAR); b.x = xb_xcc_id();
    b.st = (volatile LAS unsigned*)((LAS unsigned char*)smem + 81920 + 53248 + 2 * 144 + 128);
    xcd_barrier_(b);
}

namespace pg8 {
constexpr int BM = 256, BK = 64, HALF = 128, HTB = HALF * BK * 2, STAGE_BYTES = 8 * HTB, NXCD = 8, WGM = 8;
__device__ __forceinline__ int lds_byte(int r, int c) { const int st = (r >> 4) * 2 + (c >> 5), rr = r & 15, cc = c & 31, ob = rr * 64 + cc * 2; return st * 1024 + (ob ^ (((ob >> 9) & 1) << 5)); }
__device__ __forceinline__ void stage_rc(int b, int& R, int& C) { const int st = b / 1024, sb = b % 1024, swz = sb ^ (((sb >> 9) & 1) << 5); R = (st >> 1) * 16 + swz / 64; C = (st & 1) * 32 + (swz % 64) / 2; }
__device__ __forceinline__ int perm32(int rho) { const int n = rho >> 4, i = rho & 15; return 8 * (i >> 2) + 4 * n + (i & 3); }
struct Unit { int pm, pn; };
struct Gemm { const u16* A; const u16* Bt; int K; };
struct Sched {
    int nM, nN, nwg, G, c, br;
    __device__ __forceinline__ void init(int nM_, int nN_, int G_, int c_, int br_) { nM = nM_; nN = nN_; nwg = nM * nN; G = G_; c = c_; br = br_; }
    __device__ __forceinline__ bool next(int i, Unit& u) const {
        const int round = br ? i / 3 : i, cc = br ? i - round * 3 : 0;
        const long L = (long)round * G + c; if (L >= nwg) return false;
        int wgid = (int)L; { const int q = nwg / NXCD, r = nwg % NXCD, xcd = wgid % NXCD, off = wgid / NXCD; wgid = (xcd < r ? xcd * (q + 1) : r * (q + 1) + (xcd - r) * q) + off; }
        const int nig = WGM * nN, gid = wgid / nig, fm = gid * WGM, gsz = (nM - fm) < WGM ? (nM - fm) : WGM;
        u.pm = fm + ((wgid % nig) % gsz) + cc * nM; u.pn = (wgid % nig) / gsz + cc * nN; return true;
    }
};
template <class Epi>
__device__ __forceinline__ void gemm_phase(LAS unsigned char* lds, const Gemm g, const Sched& S, const Epi& E) {
    const int tid = fresh_tid(), wid = __builtin_amdgcn_readfirstlane(tid >> 6), lane = tid & 63, wr = wid >> 2, wc = wid & 3, fr = lane & 15, fq = lane >> 4;
    const int K = g.K, nt = K / BK;
    unsigned voffA[2], voffB[2];
#pragma unroll
    for (int i = 0; i < 2; ++i) { int R, C; stage_rc(tid * 16 + i * 8192, R, C); const int Rb = Epi::PERM ? ((R & ~31) + perm32(R & 31)) : R;
        voffA[i] = (unsigned)(R * K + C) * 2u; voffB[i] = (unsigned)(Rb * K + C) * 2u; }
    const size_t kstep = (size_t)(BK * 2);
    const size_t hstep = (size_t)HALF * K * 2;
    const size_t tstep = 2 * hstep;
    const unsigned ldsw = (unsigned)wid * 1024u;
    const int aoff = lds_byte(wr * 64 + fr, fq * 8), boff = lds_byte(wc * 32 + fr, fq * 8);
#define PG8_SA(b, h) (((b) * 2 + (h)) * HTB)
#define PG8_SB(b, h) ((4 + (b) * 2 + (h)) * HTB)
#define PG8_STAGE(bufoff, gbase, voff) do { _Pragma("unroll") for (int _i = 0; _i < 2; ++_i) \
        __builtin_amdgcn_global_load_lds((const unsigned*)((const char*)(gbase) + (voff)[_i]), (LAS unsigned*)(lds + (bufoff) + ldsw + _i * 8192), 16, 0, 0); } while (0)
#define PG8_LDA(dst, b, h) do { _Pragma("unroll") for (int m = 0; m < 4; ++m) _Pragma("unroll") for (int k = 0; k < 2; ++k) dst[m][k] = *(const LAS bf16x8*)(lds + PG8_SA(b, h) + aoff + m * 2048 + k * 1024); } while (0)
#define PG8_LDB(dst, b, h) do { _Pragma("unroll") for (int n = 0; n < 2; ++n) _Pragma("unroll") for (int k = 0; k < 2; ++k) dst[n][k] = *(const LAS bf16x8*)(lds + PG8_SB(b, h) + boff + n * 2048 + k * 1024); } while (0)
#define PG8_MMA(ai, bj, At, Bt) do { __builtin_amdgcn_s_setprio(1); _Pragma("unroll") for (int m = 0; m < 4; ++m) _Pragma("unroll") for (int n = 0; n < 2; ++n) _Pragma("unroll") for (int k = 0; k < 2; ++k) \
        acc[ai][bj][m][n] = __builtin_amdgcn_mfma_f32_16x16x32_bf16(Bt[n][k], At[m][k], acc[ai][bj][m][n], 0, 0, 0); __builtin_amdgcn_s_setprio(0); } while (0)
#define PG8_WAIT_V(n) asm volatile("s_waitcnt vmcnt(" #n ")" ::: "memory")
#define PG8_WAIT_L(n) asm volatile("s_waitcnt lgkmcnt(" #n ")" ::: "memory")
#define PG8_BAR __builtin_amdgcn_s_barrier()
#define PG8_SCHED __builtin_amdgcn_sched_barrier(0)
    Unit cur, nxt; int ui = 0;
    if (!S.next(0, cur)) return;
    f32x4 acc[2][2][4][2];
#pragma unroll
    for (int a = 0; a < 2; ++a)
#pragma unroll
        for (int b = 0; b < 2; ++b)
#pragma unroll
            for (int m = 0; m < 4; ++m)
#pragma unroll
                for (int n = 0; n < 2; ++n) acc[a][b][m][n] = (f32x4){0.f, 0.f, 0.f, 0.f};
    bf16x8 At[4][2], B0[2][2], B1[2][2];
    const char* cA = (const char*)g.A + (size_t)cur.pm * tstep; const char* cB = (const char*)g.Bt + (size_t)cur.pn * tstep;
    PG8_STAGE(PG8_SB(0, 0), cB, voffB); PG8_STAGE(PG8_SA(0, 0), cA, voffA); PG8_STAGE(PG8_SB(0, 1), cB + hstep, voffB); PG8_STAGE(PG8_SA(0, 1), cA + hstep, voffA);
    if (wr == 1) PG8_BAR;
    PG8_WAIT_V(4); PG8_BAR;
    PG8_STAGE(PG8_SB(1, 0), cB + kstep, voffB); PG8_STAGE(PG8_SA(1, 0), cA + kstep, voffA); PG8_STAGE(PG8_SB(1, 1), cB + hstep + kstep, voffB);
    PG8_WAIT_V(6); PG8_BAR;
    for (;;) {
        const bool has_next = S.next(ui + 1, nxt);
        const char* nA = has_next ? (const char*)g.A + (size_t)nxt.pm * tstep : cA; const char* nB = has_next ? (const char*)g.Bt + (size_t)nxt.pn * tstep : cB;
        for (int t = 0; t < nt; t += 2) {
            const bool last = (t == nt - 2);
            const char* a1 = cA + (size_t)(t + 1) * kstep;
            const char* a2 = last ? nA : cA + (size_t)(t + 2) * kstep; const char* b2 = last ? nB : cB + (size_t)(t + 2) * kstep;
            const char* a3 = a2 + kstep; const char* b3 = b2 + kstep;
            PG8_LDB(B0, 0, 0); PG8_SCHED; PG8_LDA(At, 0, 0); PG8_STAGE(PG8_SA(1, 1), a1 + hstep, voffA);
            PG8_WAIT_L(8); PG8_BAR; PG8_WAIT_L(0); PG8_MMA(0, 0, At, B0); PG8_BAR; PG8_SCHED;
            PG8_LDB(B1, 0, 1); PG8_STAGE(PG8_SB(0, 0), b2, voffB);
            PG8_BAR; PG8_WAIT_L(0); PG8_MMA(0, 1, At, B1); PG8_BAR;
            PG8_LDA(At, 0, 1); PG8_STAGE(PG8_SA(0, 0), a2, voffA);
            PG8_BAR; PG8_WAIT_L(0); PG8_MMA(1, 0, At, B0); PG8_BAR; PG8_SCHED;
            PG8_STAGE(PG8_SB(0, 1), b2 + hstep, voffB);
            PG8_WAIT_V(6); PG8_BAR; PG8_MMA(1, 1, At, B1); PG8_BAR;
            PG8_LDB(B0, 1, 0); PG8_SCHED; PG8_LDA(At, 1, 0); PG8_STAGE(PG8_SA(0, 1), a2 + hstep, voffA);
            PG8_WAIT_L(8); PG8_BAR; PG8_WAIT_L(0); PG8_MMA(0, 0, At, B0); PG8_BAR; PG8_SCHED;
            PG8_LDB(B1, 1, 1); PG8_STAGE(PG8_SB(1, 0), b3, voffB);
            PG8_BAR; PG8_WAIT_L(0); PG8_MMA(0, 1, At, B1); PG8_BAR;
            PG8_LDA(At, 1, 1); PG8_STAGE(PG8_SA(1, 0), a3, voffA);
            PG8_BAR; PG8_WAIT_L(0); PG8_MMA(1, 0, At, B0); PG8_BAR; PG8_SCHED;
            PG8_STAGE(PG8_SB(1, 1), b3 + hstep, voffB);
            PG8_WAIT_V(6); PG8_BAR; PG8_MMA(1, 1, At, B1); PG8_BAR;
        }
        if constexpr (!Epi::AFTER_DRAIN) E(acc, cur, wr, wc, fr, fq);
        if (!has_next) break;
#pragma unroll
        for (int a = 0; a < 2; ++a)
#pragma unroll
            for (int b = 0; b < 2; ++b)
#pragma unroll
                for (int m = 0; m < 4; ++m)
#pragma unroll
                    for (int n = 0; n < 2; ++n) acc[a][b][m][n] = (f32x4){0.f, 0.f, 0.f, 0.f};
        cur = nxt; cA = nA; cB = nB; ++ui;
    }
    PG8_WAIT_V(0);
    if (wr == 0) PG8_BAR;
    PG8_BAR;
    if constexpr (Epi::AFTER_DRAIN) E.fused(acc, cur, wr, wc, fr, fq, lds, wid, lane);
#undef PG8_SA
#undef PG8_SB
#undef PG8_STAGE
#undef PG8_LDA
#undef PG8_LDB
#undef PG8_MMA
#undef PG8_WAIT_V
#undef PG8_WAIT_L
#undef PG8_BAR
#undef PG8_SCHED
}
}

struct EpiSwiglu {
    static constexpr bool PERM = true;
    static constexpr bool AFTER_DRAIN = false;
    u16* H;
    __device__ __forceinline__ void operator()(const f32x4 (&acc)[2][2][4][2], const pg8::Unit& u, int wr, int wc, int fr, int fq) const {
        const int f = u.pn * 128 + wc * 32 + fq * 8;
#pragma unroll
        for (int ai = 0; ai < 2; ++ai)
#pragma unroll
            for (int m = 0; m < 4; ++m) {
                const int row = u.pm * 256 + ai * 128 + wr * 64 + m * 16 + fr;
                const f32x4 a0 = acc[ai][0][m][0], a1 = acc[ai][0][m][1], b0 = acc[ai][1][m][0], b1 = acc[ai][1][m][1];
                *(uint4*)(H + (size_t)row * DFF + f) = make_uint4(pack2(silu(a0[0]) * b0[0], silu(a0[1]) * b0[1]), pack2(silu(a0[2]) * b0[2], silu(a0[3]) * b0[3]),
                                                                  pack2(silu(a1[0]) * b1[0], silu(a1[1]) * b1[1]), pack2(silu(a1[2]) * b1[2], silu(a1[3]) * b1[3]));
            }
    }
};
struct EpiU {
    static constexpr bool PERM = true;
    static constexpr bool AFTER_DRAIN = false;
    u16* U; const float* LBSL;
    __device__ __forceinline__ void operator()(const f32x4 (&acc)[2][2][4][2], const pg8::Unit& u, int wr, int wc, int fr, int fq) const {
        const int mode = (u.pn < 2) ? 1 : ((u.pn >= 6 && u.pn < 10) ? 2 : 0);
#pragma unroll
        for (int bj = 0; bj < 2; ++bj) {
            const int col = u.pn * 256 + bj * 128 + wc * 32 + fq * 8;
            float4 lb0 = make_float4(0.f, 0.f, 0.f, 0.f), lb1 = lb0;
            if (mode == 2) { lb0 = *(const float4*)(LBSL + (col - HF)); lb1 = *(const float4*)(LBSL + (col + 4 - HF)); }
#pragma unroll
            for (int ai = 0; ai < 2; ++ai)
#pragma unroll
                for (int m = 0; m < 4; ++m) {
                    const int row = u.pm * 256 + ai * 128 + wr * 64 + m * 16 + fr;
                    f32x4 a = acc[ai][bj][m][0], b = acc[ai][bj][m][1];
                    if (mode == 1) {
                        a[0] = silu(a[0]); a[1] = silu(a[1]); a[2] = silu(a[2]); a[3] = silu(a[3]);
                        b[0] = silu(b[0]); b[1] = silu(b[1]); b[2] = silu(b[2]); b[3] = silu(b[3]);
                    }
                    if (mode == 2) {
                        a[0] = __logf(lb0.x + (1.f - lb0.x) * sigm(a[0])); a[1] = __logf(lb0.y + (1.f - lb0.y) * sigm(a[1]));
                        a[2] = __logf(lb0.z + (1.f - lb0.z) * sigm(a[2])); a[3] = __logf(lb0.w + (1.f - lb0.w) * sigm(a[3]));
                        b[0] = __logf(lb1.x + (1.f - lb1.x) * sigm(b[0])); b[1] = __logf(lb1.y + (1.f - lb1.y) * sigm(b[1]));
                        b[2] = __logf(lb1.z + (1.f - lb1.z) * sigm(b[2])); b[3] = __logf(lb1.w + (1.f - lb1.w) * sigm(b[3]));
                    }
                    *(uint4*)(U + (size_t)row * DINP + col) = make_uint4(pack2(a[0], a[1]), pack2(a[2], a[3]), pack2(b[0], b[1]), pack2(b[2], b[3]));
                }
        }
    }
};
struct EpiBranch {
    static constexpr bool PERM = true;
    static constexpr bool AFTER_DRAIN = false;
    const u16* U; u16* Zs; u16* G;
    __device__ __forceinline__ void operator()(const f32x4 (&acc)[2][2][4][2], const pg8::Unit& u, int wr, int wc, int fr, int fq) const {
        const int c = u.pm / 48, mt = u.pm - c * 48, nt = u.pn - c * 4;
#pragma unroll
        for (int ai = 0; ai < 2; ++ai)
#pragma unroll
            for (int m = 0; m < 4; ++m) {
                const int row = mt * 256 + ai * 128 + wr * 64 + m * 16 + fr;
#pragma unroll
                for (int bj = 0; bj < 2; ++bj) {
                    const int col = nt * 256 + bj * 128 + wc * 32 + fq * 8;
                    const uint4 gr = *(const uint4*)(U + (size_t)row * DINP + BG + c * 1024 + col);
                    const f32x4 a = acc[ai][bj][m][0], b = acc[ai][bj][m][1];
                    float v[8];
                    v[0] = sigm(bf2f(get16(gr, 0))) * a[0]; v[1] = sigm(bf2f(get16(gr, 1))) * a[1];
                    v[2] = sigm(bf2f(get16(gr, 2))) * a[2]; v[3] = sigm(bf2f(get16(gr, 3))) * a[3];
                    v[4] = sigm(bf2f(get16(gr, 4))) * b[0]; v[5] = sigm(bf2f(get16(gr, 5))) * b[1];
                    v[6] = sigm(bf2f(get16(gr, 6))) * b[2]; v[7] = sigm(bf2f(get16(gr, 7))) * b[3];
                    const size_t o = (size_t)row * D + col;
                    if (c > 0) {
                        const uint4 z = *(const uint4*)(Zs + o);
#pragma unroll
                        for (int e = 0; e < 8; ++e) v[e] += bf2f(get16(z, e));
                    }
                    *(uint4*)((c < 2 ? Zs : G) + o) = make_uint4(pack2(v[0], v[1]), pack2(v[2], v[3]), pack2(v[4], v[5]), pack2(v[6], v[7]));
                }
                asm volatile("" ::: "memory");
            }
    }
};

struct EpiResidLn {
    static constexpr bool PERM = true;
    static constexpr bool AFTER_DRAIN = true;
    u16* X; float* outp; u16* XM; const float* MODG; int goff; float gs;
    const float* lng; const float* lnb; const float* MODN; int shoff; int has_xm;
    unsigned long long* xbuf; unsigned* cnt; unsigned want;
    __device__ __forceinline__ void fused(f32x4 (&acc)[2][2][4][2], const pg8::Unit& u0, int wr, int wc, int fr, int fq, LAS unsigned char* lds, int wid, int lane) const {
        typedef float f32x2v __attribute__((ext_vector_type(2)));
        pg8::Unit u = u0;
        asm volatile("" : "+s"(u.pm), "+s"(u.pn), "+s"(wr), "+s"(wc), "+s"(wid));
        asm volatile("" : "+v"(fr), "+v"(fq), "+v"(lane));
        LAS f32x2v* P = (LAS f32x2v*)lds;
        LAS f32x2v* S = (LAS f32x2v*)(lds + 8192);
        const int ms = modset_of_row(u.pm * 256);
        {
            const float* md = MODG + (size_t)ms * 9216 + goff + u.pn * 256 + wc * 32 + fq * 8;
#pragma unroll
            for (int bj = 0; bj < 2; ++bj) {
                const float4 g0 = *(const float4*)(md + bj * 128), g1 = *(const float4*)(md + bj * 128 + 4);
                size_t xo = (size_t)(u.pm * 256 + wr * 64 + fr) * D + u.pn * 256 + wc * 32 + fq * 8 + bj * 128;
                asm volatile("" : "+v"(xo));
#pragma unroll
                for (int ai = 0; ai < 2; ++ai) {
#pragma unroll
                    for (int m = 0; m < 4; ++m) {
                        const uint4 xr_ = *(const uint4*)(X + xo);
                        f32x4 a = acc[ai][bj][m][0], b = acc[ai][bj][m][1];
                        a[0] = ALPHA * bf2f(get16(xr_, 0)) + gs * g0.x * a[0]; a[1] = ALPHA * bf2f(get16(xr_, 1)) + gs * g0.y * a[1];
                        a[2] = ALPHA * bf2f(get16(xr_, 2)) + gs * g0.z * a[2]; a[3] = ALPHA * bf2f(get16(xr_, 3)) + gs * g0.w * a[3];
                        b[0] = ALPHA * bf2f(get16(xr_, 4)) + gs * g1.x * b[0]; b[1] = ALPHA * bf2f(get16(xr_, 5)) + gs * g1.y * b[1];
                        b[2] = ALPHA * bf2f(get16(xr_, 6)) + gs * g1.z * b[2]; b[3] = ALPHA * bf2f(get16(xr_, 7)) + gs * g1.w * b[3];
                        acc[ai][bj][m][0] = a; acc[ai][bj][m][1] = b;
                        asm volatile("" : "+v"(acc[ai][bj][m][0]), "+v"(acc[ai][bj][m][1]));
                        xo += 16 * D;
                        if (m & 1) asm volatile("" : "+v"(xo) :: "memory");
                    }
                    xo += 64 * D;
                }
            }
        }
#pragma unroll
        for (int ai = 0; ai < 2; ++ai)
#pragma unroll
            for (int m = 0; m < 4; ++m) {
                float s = 0.f;
#pragma unroll
                for (int bj = 0; bj < 2; ++bj)
#pragma unroll
                    for (int n = 0; n < 2; ++n) { const f32x4 x = acc[ai][bj][m][n]; s += (x[0] + x[1]) + (x[2] + x[3]); }
                s += __shfl_xor(s, 16); s += __shfl_xor(s, 32);
                const float mw = s * (1.0f / 64.0f); float q = 0.f;
#pragma unroll
                for (int bj = 0; bj < 2; ++bj)
#pragma unroll
                    for (int n = 0; n < 2; ++n) { const f32x4 d = acc[ai][bj][m][n] - mw; q += (d[0] * d[0] + d[1] * d[1]) + (d[2] * d[2] + d[3] * d[3]); }
                q += __shfl_xor(q, 16); q += __shfl_xor(q, 32);
                if (fq == 0) P[(ai * 128 + wr * 64 + m * 16 + fr) * 4 + wc] = (f32x2v){mw, q};
            }
        asm volatile("s_waitcnt lgkmcnt(0)" ::: "memory"); __builtin_amdgcn_s_barrier(); asm volatile("" ::: "memory");
        const int row = wid * 32 + (lane & 31);
        if (lane < 32) {
            const f32x2v a = P[row * 4 + 0], b = P[row * 4 + 1], c = P[row * 4 + 2], d = P[row * 4 + 3];
            const float mt = (a.x + b.x + c.x + d.x) * 0.25f;
            const float da = a.x - mt, db = b.x - mt, dc = c.x - mt, dd = d.x - mt;
            const float m2 = (a.y + b.y) + (c.y + d.y) + 64.0f * ((da * da + db * db) + (dc * dc + dd * dd));
            unsigned long long* slot = xbuf + ((size_t)(u.pm * 256 + row) * 4 + u.pn);
            __hip_atomic_store(slot, ((unsigned long long)__float_as_uint(m2) << 32) | __float_as_uint(mt), __ATOMIC_RELAXED, __HIP_MEMORY_SCOPE_AGENT);
        }
        asm volatile("s_waitcnt vmcnt(0)" ::: "memory");
        if (lane == 0) __hip_atomic_fetch_add(cnt + 64 * u.pm, 1u, __ATOMIC_RELAXED, __HIP_MEMORY_SCOPE_AGENT);
        if (wid == 0) {
            unsigned sp = 0;
            for (;;) {
                if ((unsigned)__builtin_amdgcn_readfirstlane(__hip_atomic_load(cnt + 64 * u.pm, __ATOMIC_RELAXED, __HIP_MEMORY_SCOPE_AGENT)) >= want) break;
                if (++sp > (1u << 22)) break;
                __builtin_amdgcn_s_sleep(2);
            }
            __builtin_amdgcn_fence(__ATOMIC_ACQUIRE, "agent");
        }
        asm volatile("s_waitcnt vmcnt(0) lgkmcnt(0)" ::: "memory"); __builtin_amdgcn_s_barrier(); asm volatile("" ::: "memory");
        if (lane < 32) {
            const unsigned long long* slot = xbuf + (size_t)(u.pm * 256 + row) * 4; float mt[4], m2[4]; float msum = 0.f;
#pragma unroll
            for (int t = 0; t < 4; ++t) { const unsigned long long w = __hip_atomic_load(slot + t, __ATOMIC_RELAXED, __HIP_MEMORY_SCOPE_AGENT); mt[t] = __uint_as_float((unsigned)w); m2[t] = __uint_as_float((unsigned)(w >> 32)); msum += mt[t]; }
            const float mean = msum * 0.25f; float q = 0.f;
#pragma unroll
            for (int t = 0; t < 4; ++t) { const float dm = mt[t] - mean; q += m2[t] + 256.0f * dm * dm; }
            S[row] = (f32x2v){mean, 1.0f / sqrtf(q * (1.0f / 1024.0f) + 1e-5f)};
        }
        asm volatile("s_waitcnt lgkmcnt(0)" ::: "memory"); __builtin_amdgcn_s_barrier(); asm volatile("" ::: "memory");
        asm volatile("" : "+s"(u.pm), "+s"(u.pn), "+s"(wr), "+s"(wc));
        asm volatile("" : "+v"(fr), "+v"(fq));
        {
            const int cb0 = u.pn * 256 + wc * 32 + fq * 8;
            const float* mdn = MODN + (size_t)ms * 9216 + shoff + cb0;
#pragma unroll
            for (int bj = 0; bj < 2; ++bj) {
                const int co = bj * 128;
                const float4 gg0 = *(const float4*)(lng + cb0 + co), gg1 = *(const float4*)(lng + cb0 + co + 4);
                const float4 bb0 = *(const float4*)(lnb + cb0 + co), bb1 = *(const float4*)(lnb + cb0 + co + 4);
                float4 sh0 = make_float4(0.f, 0.f, 0.f, 0.f), sh1 = sh0, sc0 = sh0, sc1 = sh0;
                if (has_xm) { sh0 = *(const float4*)(mdn + co); sh1 = *(const float4*)(mdn + co + 4); sc0 = *(const float4*)(mdn + 1024 + co); sc1 = *(const float4*)(mdn + 1024 + co + 4); }
                size_t o = (size_t)(u.pm * 256 + wr * 64 + fr) * D + cb0 + co;
                int r = wr * 64 + fr;
                asm volatile("" : "+v"(o), "+v"(r));
#pragma unroll
                for (int ai = 0; ai < 2; ++ai) {
#pragma unroll
                    for (int m = 0; m < 4; ++m) {
                        const f32x2v sr = S[r];
                        const f32x4 a = acc[ai][bj][m][0], b = acc[ai][bj][m][1];
                        const float x0 = (a[0] - sr.x) * sr.y * gg0.x + bb0.x, x1 = (a[1] - sr.x) * sr.y * gg0.y + bb0.y;
                        const float x2 = (a[2] - sr.x) * sr.y * gg0.z + bb0.z, x3 = (a[3] - sr.x) * sr.y * gg0.w + bb0.w;
                        const float x4 = (b[0] - sr.x) * sr.y * gg1.x + bb1.x, x5 = (b[1] - sr.x) * sr.y * gg1.y + bb1.y;
                        const float x6 = (b[2] - sr.x) * sr.y * gg1.z + bb1.z, x7 = (b[3] - sr.x) * sr.y * gg1.w + bb1.w;
                        if (has_xm) {
                            *(uint4*)(X + o) = make_uint4(pack2(x0, x1), pack2(x2, x3), pack2(x4, x5), pack2(x6, x7));
                            *(uint4*)(XM + o) = make_uint4(pack2(x0 * (1.f + sc0.x) + sh0.x, x1 * (1.f + sc0.y) + sh0.y), pack2(x2 * (1.f + sc0.z) + sh0.z, x3 * (1.f + sc0.w) + sh0.w),
                                                           pack2(x4 * (1.f + sc1.x) + sh1.x, x5 * (1.f + sc1.y) + sh1.y), pack2(x6 * (1.f + sc1.z) + sh1.z, x7 * (1.f + sc1.w) + sh1.w));
                        } else {
                            *(float4*)(outp + o) = make_float4(x0, x1, x2, x3);
                            *(float4*)(outp + o + 4) = make_float4(x4, x5, x6, x7);
                        }
                        o += 16 * D; r += 16;
                        asm volatile("" : "+v"(o), "+v"(r) :: "memory");
                    }
                    o += 64 * D; r += 64;
                }
            }
        }
    }
};

__device__ __forceinline__ void convert_on_idle(const Params& p, int l, int part, unsigned char* smem) {
    const int bid = fresh_bid();
    if (l + 1 < 4 && bid >= 192) {
#pragma unroll 1
        for (int k = 0; k < 7; ++k) convert_tile(p, l + 1, part * 448 + (bid - 192) * 7 + k, smem);
    }
}
__device__ __forceinline__ void phase_ffn_up(const Params& p, int l, int i, unsigned char* smem) {
    pg8::Gemm g{(const u16*)(p.ws + OFF_XM), (const u16*)(p.ws + OFF_WGU + (size_t)(l & 1) * WSET) + (size_t)i * 5632 * 1024, 1024};
    pg8::Sched S; S.init(48, 22, (int)gridDim.x, fresh_bid(), 0);
    EpiSwiglu E{(u16*)(p.ws + OFF_U)};
    pg8::gemm_phase((LAS unsigned char*)smem, g, S, E);
}
__device__ __forceinline__ void phase_gemm_resid_ln(const Params& p, int l, const u16* A, const u16* W, int K, int goff, float gs, int lni, int ml, int shoff, bool final_, unsigned char* smem) {
    pg8::Gemm g{A, W, K};
    pg8::Sched S; S.init(48, 4, (int)gridDim.x, fresh_bid(), 0);
    const float* MOD = (const float*)(p.ws + OFF_MOD);
    EpiResidLn E{(u16*)(p.ws + OFF_X), p.out, (u16*)(p.ws + OFF_XM), MOD + (size_t)l * 5 * 9216, goff, gs,
                 p.in[11] + (size_t)(l * 3 + lni) * D, p.in[12] + (size_t)(l * 3 + lni) * D, MOD + (size_t)ml * 5 * 9216, shoff, final_ ? 0 : 1,
                 (unsigned long long*)(p.ws + OFF_XBUF), (unsigned*)(p.ws + OFF_LNCNT), 32u * (unsigned)(l * 3 + lni + 1)};
    pg8::gemm_phase((LAS unsigned char*)smem, g, S, E);
    convert_on_idle(p, l, lni == 0 ? 0 : (lni == 1 ? 2 : 3), smem);
}
__device__ __forceinline__ void phase_inproj(const Params& p, int l, unsigned char* smem) {
    pg8::Gemm g{(const u16*)(p.ws + OFF_XM), (const u16*)(p.ws + OFF_WIN + (size_t)(l & 1) * WSET), 1024};
    pg8::Sched S; S.init(48, 36, (int)gridDim.x, fresh_bid(), 0);
    EpiU E{(u16*)(p.ws + OFF_U), (const float*)(p.ws + OFF_LBS) + l * 1024};
    pg8::gemm_phase((LAS unsigned char*)smem, g, S, E);
}
__device__ __forceinline__ void phase_branch(const Params& p, int l, unsigned char* smem) {
    pg8::Gemm g{(const u16*)(p.ws + OFF_Y), (const u16*)(p.ws + OFF_WBR + (size_t)(l & 1) * WSET), 512};
    pg8::Sched S; S.init(48, 4, (int)gridDim.x, fresh_bid(), 1);
    EpiBranch E{(const u16*)(p.ws + OFF_U), (u16*)(p.ws + OFF_Z), (u16*)(p.ws + OFF_G)};
    pg8::gemm_phase((LAS unsigned char*)smem, g, S, E);
    convert_on_idle(p, l, 1, smem);
}

__device__ __forceinline__ float conv_xbc(const u16* U, int t0, int L, int pos, int c, float w0, float w1, float w2, float bias) {
    const u16* base = U + (size_t)t0 * DINP + MXBC + c;
    float m1 = bf2f(base[(size_t)pos * DINP]);
    float m0 = pos > 0 ? bf2f(base[(size_t)(pos - 1) * DINP]) : 0.f;
    float m2 = pos + 1 < L ? bf2f(base[(size_t)(pos + 1) * DINP]) : 0.f;
    return silu(w0 * m0 + w1 * m1 + w2 * m2 + bias);
}

#define WL128(j, v, coff) { const int ch_ = tid + (j) * 256, i_ = ch_ >> 4, cc_ = ch_ & 15; const int pos_ = dir ? (L - 1 - (cbase + i_)) : (cbase + i_); \
    v = *(const uint4*)(U + (size_t)(t0 + pos_) * DINP + (coff) + cc_ * 8); }
#define WS128(j, v, dst) { const int ch_ = tid + (j) * 256, i_ = ch_ >> 4, cc_ = ch_ & 15; *(uint4*)((dst) + i_ * 136 + cc_ * 8) = v; }
#define WL64(j, v, coff) { const int ch_ = tid + (j) * 256, i_ = ch_ >> 3, cc_ = ch_ & 7; const int pos_ = dir ? (L - 1 - (cbase + i_)) : (cbase + i_); \
    v = *(const uint4*)(U + (size_t)(t0 + pos_) * DINP + (coff) + cc_ * 8); }
#define WL64G(j, v, base, stride, coff) { const int ch_ = tid + (j) * 256, i_ = ch_ >> 3, cc_ = ch_ & 7; const int pos_ = dir ? (L - 1 - (cbase + i_)) : (cbase + i_); \
    v = *(const uint4*)((base) + (size_t)(t0 + pos_) * (stride) + (coff) + cc_ * 8); }
#define WS64(j, v, dst) { const int ch_ = tid + (j) * 256, i_ = ch_ >> 3, cc_ = ch_ & 7; *(uint4*)((dst) + i_ * 136 + cc_ * 8) = v; }
#define WST64(j, v) { const int ch_ = tid + (j) * 256, i_ = ch_ >> 3, cc_ = ch_ & 7; _Pragma("unroll") for (int e_ = 0; e_ < 8; ++e_) Vts[(cc_ * 8 + e_) * 72 + (i_ ^ (cc_ << 3))] = get16(v, e_); }

template <int MX>
__device__ __forceinline__ void scan_item(const Params& p, int l, int sq, int dir, int h, int vhalf, unsigned char* smem) {
    constexpr int DK = (MX == 2) ? 64 : 128;
    constexpr int NKT = DK / 32;
    const int tid = fresh_tid() & 255, lane = tid & 63, w = tid >> 6, wm = w >> 1, wn = w & 1, lr = lane & 15, lq = lane >> 4;
    u16* Qs = (u16*)smem;
    u16* Ks = Qs + 64 * 136;
    u16* Kts = Ks + 64 * 136;
    u16* Vts = Kts + 128 * 72;
    u16* Sts = Vts + 64 * 72;
    float* fa = (float*)(Sts + 64 * 136);
    u16* ATT = (MX == 2) ? (Kts + 64 * 72) : Ks;
    float* scal = (float*)(Vts + 64);
    float* rowv = fa, *colv = fa + 64, *rsv = fa + 128, *kwv = fa + 192;
    float* f256 = fa + 256, *f320 = fa + 320, *f384 = fa + 384;

    const bool lat = sq >= 32;
    const int bidx = lat ? sq - 32 : sq;
    const int t0 = lat ? TCTX + bidx * 1024 : sq * 256;
    const int L = lat ? 1024 : 256;
    const int nchunk = L >> 6;
    const u16* U = (const u16*)(p.ws + OFF_U);
    u16* O = (u16*)(p.ws + OFF_O) + (size_t)(MX * 2 + dir) * TT * 512;
    const int NH = (MX == 2) ? 8 : 4;
    const size_t sidx = ((size_t)(bidx * 4 + l) * 2 + dir) * NH + h;

    f32x4 S[2][NKT];
    if (lat) {
        if (MX == 2) {
            const float* sp = p.in[6] + sidx * 4096;
#pragma unroll
            for (int mi = 0; mi < 2; ++mi)
#pragma unroll
                for (int ni = 0; ni < NKT; ++ni)
#pragma unroll
                    for (int r = 0; r < 4; ++r) {
                        int v = wm * 32 + mi * 16 + lq * 4 + r, k = wn * (DK / 2) + ni * 16 + lr;
                        S[mi][ni][r] = sp[v * 64 + k];
                    }
        } else {
            const float* sp = (MX == 0 ? p.in[2] : p.in[3]) + sidx * 16384;
#pragma unroll
            for (int mi = 0; mi < 2; ++mi)
#pragma unroll
                for (int ni = 0; ni < NKT; ++ni) {
                    int v = vhalf * 64 + wm * 32 + mi * 16 + lq * 4, k = wn * (DK / 2) + ni * 16 + lr;
                    float4 t = *(const float4*)(sp + k * 128 + v);
                    S[mi][ni] = (f32x4){t.x, t.y, t.z, t.w};
                }
        }
    } else {
#pragma unroll
        for (int mi = 0; mi < 2; ++mi)
#pragma unroll
            for (int ni = 0; ni < NKT; ++ni) S[mi][ni] = (f32x4){0.f, 0.f, 0.f, 0.f};
    }
    float mcar = 0.f, gb_i = 0.f, gb_f = 0.f;
    if (MX == 1) {
        if (lat) mcar = p.in[5][sidx];
        gb_i = p.in[18][((l * 2 + 0) * 2 + dir) * 4 + h];
        gb_f = p.in[18][((l * 2 + 1) * 2 + dir) * 4 + h];
        if (tid < 128) f384[tid] = lat ? p.in[4][sidx * 128 + tid] : 0.f;
    }
    float dtb = 0.f, aexp = 0.f;
    if (MX == 2) {
        dtb = p.in[22][(l * 2 + dir) * 8 + h];
        aexp = expf(p.in[23][(l * 2 + dir) * 8 + h]);
    }
    if (MX != 0) {
#pragma unroll
        for (int mi = 0; mi < 2; ++mi)
#pragma unroll
            for (int ni = 0; ni < NKT; ++ni) {
                const int k = wn * (DK / 2) + ni * 16 + lr;
#pragma unroll
                for (int r = 0; r < 4; ++r) Sts[(wm * 32 + mi * 16 + lq * 4 + r) * 136 + k] = f2bf(S[mi][ni][r]);
            }
    }
    __syncthreads();

    unsigned sink = 0u;
    for (int c = 0; c < nchunk; ++c) {
        float a_dec = 1.f, m_next = 0.f;
        const int cbase = c * 64;
        if (MX == 0) {
            uint4 rf0, rf1, rf2, rf3, rq0, rq1, rq2, rq3, rv0, rv1;
            const int cf_ = HF + dir * 512 + h * 128, cq_ = HQ + h * 128, cv_ = HI + h * 128 + vhalf * 64;
            WL128(0, rf0, cf_) WL128(1, rf1, cf_) WL128(2, rf2, cf_) WL128(3, rf3, cf_)
            WL128(0, rq0, cq_) WL128(1, rq1, cq_) WL128(2, rq2, cq_) WL128(3, rq3, cq_)
            WL64(0, rv0, cv_) WL64(1, rv1, cv_)
            if (c + 1 < nchunk) {
                const int i_ = tid >> 2, q4 = tid & 3;
                const int posn = dir ? (L - 1 - (cbase + 64 + i_)) : (cbase + 64 + i_);
                const volatile u16* rowp = (const volatile u16*)(U + (size_t)(t0 + posn) * DINP);
                int c0, c1 = -1;
                if (MX == 0) {
                        c0 = (q4 < 2) ? (HF + dir * 512 + h * 128 + q4 * 64) : (HQ + h * 128 + (q4 - 2) * 64);
                        if (q4 == 0) c1 = HI + h * 128 + vhalf * 64;
                } else if (MX == 1) {
                        c0 = (q4 < 2) ? (MQ + h * 128 + q4 * 64) : (MK + h * 128 + (q4 - 2) * 64);
                        if (q4 == 0) c1 = MV + h * 128 + vhalf * 64;
                        if (q4 == 1) c1 = MI;
                } else {
                        const int g_ = h >> 2;
                        c0 = (q4 == 0) ? (MXBC + 640 + g_ * 64) : (q4 == 1) ? (MXBC + 512 + g_ * 64) : (q4 == 2) ? (MXBC + h * 64) : (MDT + dir * 8 + h);
                        if (q4 < 3) c1 = c0 + 63;
                }
                sink += rowp[c0];
                if (c1 >= 0) sink += rowp[c1];
            }
            WS128(0, rf0, Ks) WS128(1, rf1, Ks) WS128(2, rf2, Ks) WS128(3, rf3, Ks)
            WS128(0, rq0, Qs) WS128(1, rq1, Qs) WS128(2, rq2, Qs) WS128(3, rq3, Qs)
            WST64(0, rv0) WST64(1, rv1)
            __syncthreads();
            const int k = tid & 127, half = tid >> 7;
            float run = 0.f;
#pragma unroll 8
            for (int j = 0; j < 32; ++j) run += bf2f(Ks[(half * 32 + j) * 136 + k]);
            (half ? f384 : f256)[k] = run;
            __syncthreads();
            const float t0v = f256[k], t1v = f384[k];
            const float e1 = __expf(t1v);
            float r = half ? 0.f : -t0v;
            float kt8[8];
#pragma unroll
            for (int j = 0; j < 32; ++j) {
                const int i = half * 32 + j;
                const float lf = bf2f(Ks[i * 136 + k]);
                r += lf;
                const float kk = 1.f - __expf(lf);
                const float er = __expf(fminf(fmaxf(r, -80.f), 80.f)), ier = __builtin_amdgcn_rcpf(er);
                const float q = bf2f(Qs[i * 136 + k]);
                Qs[i * 136 + k] = f2bf(q * er);
                Ks[i * 136 + k] = f2bf(kk * ier);
                kt8[j & 7] = kk * ier * e1;
                if ((j & 7) == 7) *(uint4*)(Kts + k * 72 + (i - 7)) = make_uint4(pack2(kt8[0], kt8[1]), pack2(kt8[2], kt8[3]), pack2(kt8[4], kt8[5]), pack2(kt8[6], kt8[7]));
            }
        } else if (MX == 1) {
            uint4 rq0, rq1, rq2, rq3, rk0, rk1, rk2, rk3, rv0, rv1;
            float g_i = 0.f, g_f = 0.f;
            if (w == 0) {
                const int pos = dir ? (L - 1 - (cbase + lane)) : (cbase + lane);
                const u16* rowp = U + (size_t)(t0 + pos) * DINP;
                g_i = bf2f(rowp[MI + dir * 4 + h]);
                g_f = bf2f(rowp[MF + dir * 4 + h]);
            }
            const int cq_ = MQ + h * 128, ck_ = MK + h * 128, cv_ = MV + h * 128 + vhalf * 64;
            WL128(0, rq0, cq_) WL128(1, rq1, cq_) WL128(2, rq2, cq_) WL128(3, rq3, cq_)
            WL128(0, rk0, ck_) WL128(1, rk1, ck_) WL128(2, rk2, ck_) WL128(3, rk3, ck_)
            WL64(0, rv0, cv_) WL64(1, rv1, cv_)
        if (c + 1 < nchunk) {
            const int i_ = tid >> 2, q4 = tid & 3;
            const int posn = dir ? (L - 1 - (cbase + 64 + i_)) : (cbase + 64 + i_);
            const volatile u16* rowp = (const volatile u16*)(U + (size_t)(t0 + posn) * DINP);
            int c0, c1 = -1;
            if (MX == 0) {
                c0 = (q4 < 2) ? (HF + dir * 512 + h * 128 + q4 * 64) : (HQ + h * 128 + (q4 - 2) * 64);
                if (q4 == 0) c1 = HI + h * 128 + vhalf * 64;
            } else if (MX == 1) {
                c0 = (q4 < 2) ? (MQ + h * 128 + q4 * 64) : (MK + h * 128 + (q4 - 2) * 64);
                if (q4 == 0) c1 = MV + h * 128 + vhalf * 64;
                if (q4 == 1) c1 = MI;
            } else {
                const int g_ = h >> 2;
                c0 = (q4 == 0) ? (MXBC + 640 + g_ * 64) : (q4 == 1) ? (MXBC + 512 + g_ * 64) : (q4 == 2) ? (MXBC + h * 64) : (MDT + dir * 8 + h);
                if (q4 < 3) c1 = c0 + 63;
            }
            sink += rowp[c0];
            if (c1 >= 0) sink += rowp[c1];
        }
            if (w == 0) {
                const int i = lane;
                float ig = g_i + gb_i;
                float xf = g_f + gb_f;
                float b = -__logf(1.f + __expf(-xf));
#pragma unroll
                for (int o = 1; o < 64; o <<= 1) { float t = __shfl_up(b, o); if (lane >= o) b += t; }
                float u = ig - b;
                float pm = u;
#pragma unroll
                for (int o = 1; o < 64; o <<= 1) { float t = __shfl_up(pm, o); if (lane >= o) pm = fmaxf(pm, t); }
                float blast = __shfl(b, 63), pmlast = __shfl(pm, 63);
                float gmax = blast + pmlast;
                float mnew = fmaxf(blast + mcar, gmax);
                float mt = b + fmaxf(mcar, pm);
                rowv[i] = b - mt; colv[i] = u - 2.4260151319598084f; rsv[i] = __expf(b + mcar - mt);
                kwv[i] = __expf(blast + u - mnew) * 0.08838834764831845f; f256[i] = __expf(-mt);
                if (lane == 0) { scal[0] = __expf(blast + mcar - mnew); scal[1] = mnew; }
            }
            WS128(0, rq0, Qs) WS128(1, rq1, Qs) WS128(2, rq2, Qs) WS128(3, rq3, Qs)
            WS128(0, rk0, Ks) WS128(1, rk1, Ks) WS128(2, rk2, Ks) WS128(3, rk3, Ks)
            WST64(0, rv0) WST64(1, rv1)
            __syncthreads();
            a_dec = scal[0]; m_next = scal[1];
            {
                const int k = tid & 127, half = tid >> 7;
#pragma unroll
                for (int j8 = 0; j8 < 4; ++j8) {
                    const int i0 = half * 32 + j8 * 8;
                    float kt8[8];
#pragma unroll
                    for (int e = 0; e < 8; ++e) kt8[e] = bf2f(Ks[(i0 + e) * 136 + k]) * kwv[i0 + e];
                    *(uint4*)(Kts + k * 72 + i0) = make_uint4(pack2(kt8[0], kt8[1]), pack2(kt8[2], kt8[3]), pack2(kt8[4], kt8[5]), pack2(kt8[6], kt8[7]));
                }
            }
        } else {
            const int g = h >> 2;
            const u16* XBC = (const u16*)(p.ws + OFF_Z);
            float g_dt = 0.f;
            if (w == 0) {
                const int pos = dir ? (L - 1 - (cbase + lane)) : (cbase + lane);
                g_dt = bf2f(U[(size_t)(t0 + pos) * DINP + MDT + dir * 8 + h]);
            }
            uint4 rc0, rc1, rb0, rb1, rx0, rx1;
            WL64G(0, rc0, XBC, 768, 640 + g * 64) WL64G(1, rc1, XBC, 768, 640 + g * 64)
            WL64G(0, rb0, XBC, 768, 512 + g * 64) WL64G(1, rb1, XBC, 768, 512 + g * 64)
            WL64G(0, rx0, XBC, 768, h * 64) WL64G(1, rx1, XBC, 768, h * 64)
            if (c + 1 < nchunk) {
                const int i_ = tid >> 2, q4 = tid & 3;
                const int posn = dir ? (L - 1 - (cbase + 64 + i_)) : (cbase + 64 + i_);
                const volatile u16* xr_ = (const volatile u16*)(XBC + (size_t)(t0 + posn) * 768);
                const volatile u16* ur_ = (const volatile u16*)(U + (size_t)(t0 + posn) * DINP);
                if (q4 == 0) sink += xr_[640 + g * 64];
                else if (q4 == 1) sink += xr_[512 + g * 64];
                else if (q4 == 2) sink += xr_[h * 64];
                else sink += ur_[MDT + dir * 8 + h];
            }
            if (w == 0) {
                const int i = lane;
                float dt = g_dt + dtb;
                dt = (dt > 20.f) ? dt : __logf(1.f + __expf(dt));
                float a = -dt * aexp;
#pragma unroll
                for (int o = 1; o < 64; o <<= 1) { float t = __shfl_up(a, o); if (lane >= o) a += t; }
                float alast = __shfl(a, 63);
                rowv[i] = a; colv[i] = -a; rsv[i] = __expf(a); kwv[i] = __expf(alast - a); f256[i] = dt;
                if (lane == 0) { scal[0] = __expf(alast); scal[1] = 0.f; }
            }
            WS64(0, rc0, Qs) WS64(1, rc1, Qs)
            WS64(0, rb0, Ks) WS64(1, rb1, Ks)
            __syncthreads();
            a_dec = scal[0];
            {
#pragma unroll
                for (int j = 0; j < 2; ++j) {
                    const int ch_ = tid + j * 256, i_ = ch_ >> 3, cc_ = ch_ & 7;
                    const float dti = f256[i_];
                    const uint4 xv = j ? rx1 : rx0;
#pragma unroll
                    for (int e = 0; e < 8; ++e) Vts[(cc_ * 8 + e) * 72 + (i_ ^ (cc_ << 3))] = f2bf(bf2f(get16(xv, e)) * dti);
                }
                const int ch = tid & 63, grp = tid >> 6;
#pragma unroll
                for (int j8 = 0; j8 < 2; ++j8) {
                    const int i0 = grp * 16 + j8 * 8;
                    float kt8[8];
#pragma unroll
                    for (int e = 0; e < 8; ++e) kt8[e] = bf2f(Ks[(i0 + e) * 136 + ch]) * kwv[i0 + e];
                    *(uint4*)(Kts + ch * 72 + i0) = make_uint4(pack2(kt8[0], kt8[1]), pack2(kt8[2], kt8[3]), pack2(kt8[4], kt8[5]), pack2(kt8[6], kt8[7]));
                }
            }
        }
        __syncthreads();
        const bool s_zero = (!lat) && (c == 0);
        if (MX == 0 && !s_zero) {
#pragma unroll
            for (int mi = 0; mi < 2; ++mi)
#pragma unroll
                for (int ni = 0; ni < NKT; ++ni) {
                    const int k = wn * (DK / 2) + ni * 16 + lr;
                    const float sc = __expf(f256[k]);
#pragma unroll
                    for (int r = 0; r < 4; ++r) {
                        const int v = wm * 32 + mi * 16 + lq * 4 + r;
                        Sts[v * 136 + k] = f2bf(S[mi][ni][r] * sc);
                    }
                }
            __syncthreads();
        }
        if (MX == 1) {
            const int t = tid >> 2, part = tid & 3;
            float sacc = 0.f;
#pragma unroll
            for (int j = 0; j < 4; ++j) {
                const uint4 qv = *(const uint4*)(Qs + t * 136 + part * 32 + j * 8);
                {
                    const float4 n0 = *(const float4*)(f384 + part * 32 + j * 8), n1 = *(const float4*)(f384 + part * 32 + j * 8 + 4);
                    sacc += bf2f(get16(qv, 0)) * n0.x + bf2f(get16(qv, 1)) * n0.y + bf2f(get16(qv, 2)) * n0.z + bf2f(get16(qv, 3)) * n0.w
                          + bf2f(get16(qv, 4)) * n1.x + bf2f(get16(qv, 5)) * n1.y + bf2f(get16(qv, 6)) * n1.z + bf2f(get16(qv, 7)) * n1.w;
                }
            }
            sacc += __shfl_xor(sacc, 1); sacc += __shfl_xor(sacc, 2);
            if (part == 0) f320[t] = sacc;
        }
        f32x4 att[2][2], o[2][2];
#pragma unroll
        for (int a = 0; a < 2; ++a)
#pragma unroll
            for (int b = 0; b < 2; ++b) { att[a][b] = (f32x4){0.f, 0.f, 0.f, 0.f}; o[a][b] = (f32x4){0.f, 0.f, 0.f, 0.f}; }
        mma_nt<2, 2>(att, Qs + (wm * 32) * 136, 136, Ks + (wn * 32) * 136, 136, DK, lane);
        if (!s_zero) mma_nt<2, 2>(o, Sts + (wn * 32) * 136, 136, Qs + (wm * 32) * 136, 136, DK, lane);
        if (MX != 0) {
#pragma unroll
            for (int ti = 0; ti < 2; ++ti) {
                const float sc = rsv[wm * 32 + ti * 16 + lr];
#pragma unroll
                for (int vi = 0; vi < 2; ++vi)
#pragma unroll
                    for (int r = 0; r < 4; ++r) o[vi][ti][r] *= sc;
            }
        }
        if (MX != 2) __syncthreads();
#pragma unroll
        for (int mi = 0; mi < 2; ++mi)
#pragma unroll
            for (int ni = 0; ni < 2; ++ni)
#pragma unroll
                for (int r = 0; r < 4; ++r) {
                    const int t = wm * 32 + mi * 16 + lq * 4 + r, s = wn * 32 + ni * 16 + lr;
                    float val = 0.f;
                    if (s <= t) {
                        val = att[mi][ni][r];
                        if (MX != 0) val *= __expf(rowv[t] + colv[s]);
                    }
                    ATT[t * 72 + s] = f2bf(val);
                }
        __syncthreads();
        mma_nt<2, 2, true, false>(o, Vts + (wn * 32) * 72, 72, ATT + (wm * 32) * 72, 72, 64, lane, wn * 32, 0);
        __builtin_amdgcn_sched_barrier(0);
        if (MX == 1) {
            {
                const int t = tid >> 2, part = tid & 3;
                float sacc = 0.f;
#pragma unroll
                for (int j = 0; j < 2; ++j) {
                    const uint4 av = *(const uint4*)(ATT + t * 72 + part * 16 + j * 8);
#pragma unroll
                    for (int e = 0; e < 8; ++e) sacc += bf2f(get16(av, e));
                }
                sacc += __shfl_xor(sacc, 1); sacc += __shfl_xor(sacc, 2);
                if (part == 0) {
                    float den = sacc + rsv[t] * f320[t];
                    f320[t] = fmaxf(fabsf(den), f256[t]);
                }
            }
        }
        __builtin_amdgcn_sched_barrier(0);
        {
            f32x4 Sn[2][NKT];
#pragma unroll
            for (int mi = 0; mi < 2; ++mi)
#pragma unroll
                for (int ni = 0; ni < NKT; ++ni) Sn[mi][ni] = (f32x4){0.f, 0.f, 0.f, 0.f};
            mma_nt<2, NKT, true, false>(Sn, Vts + (wm * 32) * 72, 72, Kts + (wn * (DK / 2)) * 72, 72, 64, lane, wm * 32, 0);
#pragma unroll
            for (int mi = 0; mi < 2; ++mi)
#pragma unroll
                for (int ni = 0; ni < NKT; ++ni) {
                    const int k = wn * (DK / 2) + ni * 16 + lr;
                    const float dec = (MX == 0) ? __expf(f256[k] + f384[k]) : a_dec;
#pragma unroll
                    for (int r = 0; r < 4; ++r) S[mi][ni][r] = dec * S[mi][ni][r] + Sn[mi][ni][r];
                }
        }
        if (MX != 0) {
#pragma unroll
            for (int mi = 0; mi < 2; ++mi)
#pragma unroll
                for (int ni = 0; ni < NKT; ++ni) {
                    const int k = wn * (DK / 2) + ni * 16 + lr;
#pragma unroll
                    for (int r = 0; r < 4; ++r) Sts[(wm * 32 + mi * 16 + lq * 4 + r) * 136 + k] = f2bf(S[mi][ni][r]);
                }
        }
        __builtin_amdgcn_sched_barrier(0);
        if (MX == 1) {
            {
                const int k = tid >> 1, part = tid & 1;
                float sacc = 0.f;
#pragma unroll
                for (int j = 0; j < 4; ++j) {
                    const uint4 kv = *(const uint4*)(Kts + k * 72 + part * 32 + j * 8);
#pragma unroll
                    for (int e = 0; e < 8; ++e) sacc += bf2f(get16(kv, e));
                }
                sacc += __shfl_xor(sacc, 1);
                if (part == 0) f384[k] = a_dec * f384[k] + sacc;
            }
            __syncthreads();
        }
#pragma unroll
        for (int ti = 0; ti < 2; ++ti) {
            const int t = wm * 32 + ti * 16 + lr;
            const int pos = dir ? (L - 1 - (c * 64 + t)) : (c * 64 + t);
            const float inv = (MX == 1) ? 1.f / f320[t] : 1.f;
#pragma unroll
            for (int vi = 0; vi < 2; ++vi) {
                const int v = wn * 32 + vi * 16 + lq * 4;
                const int col = (MX == 2) ? (h * 64 + v) : (h * 128 + vhalf * 64 + v);
                *(uint2*)(O + (size_t)(t0 + pos) * 512 + col) = make_uint2(pack2(o[vi][ti][0] * inv, o[vi][ti][1] * inv), pack2(o[vi][ti][2] * inv, o[vi][ti][3] * inv));
            }
        }
        if (MX == 1) mcar = m_next;
        __syncthreads();
    }
    if (sink == 0x7fffdeadu) ((volatile unsigned*)(p.ws + OFF_CTR))[60] = sink;
    if (!lat) {
        const int o0 = TT * D;
        if (MX == 0 || MX == 1) {
            float* dst = p.out + o0 + (MX == 0 ? 0 : 16777216) + sidx * 16384;
#pragma unroll
            for (int mi = 0; mi < 2; ++mi)
#pragma unroll
                for (int ni = 0; ni < NKT; ++ni) {
                    int v = vhalf * 64 + wm * 32 + mi * 16 + lq * 4, k = wn * (DK / 2) + ni * 16 + lr;
                    *(float4*)(dst + k * 128 + v) = make_float4(S[mi][ni][0], S[mi][ni][1], S[mi][ni][2], S[mi][ni][3]);
                }
            if (MX == 1 && vhalf == 0) {
                if (tid < 128) p.out[o0 + 2 * 16777216 + sidx * 128 + tid] = f384[tid];
                if (tid == 0) p.out[o0 + 2 * 16777216 + 131072 + sidx] = mcar;
            }
        } else {
            float* dst = p.out + o0 + 2 * 16777216 + 131072 + 1024 + sidx * 4096;
#pragma unroll
            for (int mi = 0; mi < 2; ++mi)
#pragma unroll
                for (int ni = 0; ni < NKT; ++ni)
#pragma unroll
                    for (int r = 0; r < 4; ++r) {
                        int v = wm * 32 + mi * 16 + lq * 4 + r, k = wn * (DK / 2) + ni * 16 + lr;
                        dst[v * 64 + k] = S[mi][ni][r];
                    }
        }
    }
    __syncthreads();
}

__device__ __forceinline__ void phase_scan(const Params& p, int l, unsigned char* smem) {
    int* ctr = (int*)(p.ws + OFF_CTR) + l;
    int* qslot = (int*)((u16*)smem + 2 * 64 * 136 + 128 * 72 + 72 + 64);
    const int grp = fresh_tid() >> 8;
    unsigned char* gsm = smem + grp * 81920;
    for (;;) {
        if (fresh_tid() == 0) *qslot = atomicAdd(ctr, 1);
        __syncthreads();
        const int pr = *qslot;
        __syncthreads();
        if (pr >= 864) break;
        const int idx = 2 * pr + grp;
        int mx, sq, r2;
        if (idx < 192) { mx = idx / 64; int r = idx % 64; sq = 32 + r / 16; r2 = r % 16; }
        else { int j = idx - 192; mx = j / 512; int r = j % 512; sq = r / 16; r2 = r % 16; }
        const int dir = r2 >> 3;
        if (mx == 0) scan_item<0>(p, l, sq, dir, (r2 >> 1) & 3, r2 & 1, gsm);
        else if (mx == 1) scan_item<1>(p, l, sq, dir, (r2 >> 1) & 3, r2 & 1, gsm);
        else scan_item<2>(p, l, sq, dir, r2 & 7, 0, gsm);
    }
}

__device__ __forceinline__ void phase_conv(const Params& p, int l) {
    const u16* U = (const u16*)(p.ws + OFF_U);
    u16* XBC = (u16*)(p.ws + OFF_Z);
    const float* cw = p.in[20] + (size_t)l * 3 * 768;
    const float* cb = p.in[21] + (size_t)l * 768;
    const int tid = fresh_tid();
    const int cstride = gridDim.x * NTHR;
    for (int task0 = fresh_bid() * NTHR + tid; task0 < TT * 96; task0 += 2 * cstride) {
        uint4 x0[2], x1[2], x2[2]; int tokv[2], c0v[2]; bool okv[2];
#pragma unroll
        for (int r = 0; r < 2; ++r) {
            const int task = task0 + r * cstride;
            okv[r] = task < TT * 96;
            const int tk = okv[r] ? task : task0;
            const int tok = tk / 96, c0 = (tk - tok * 96) * 8;
            tokv[r] = tok; c0v[r] = c0;
            int L, pos;
            if (tok < TCTX) { L = 256; pos = tok & 255; } else { L = 1024; pos = (tok - TCTX) & 1023; }
            const u16* ur = U + (size_t)tok * DINP + MXBC + c0;
            x1[r] = *(const uint4*)ur;
            x0[r] = make_uint4(0, 0, 0, 0); x2[r] = make_uint4(0, 0, 0, 0);
            if (pos > 0) x0[r] = *(const uint4*)(ur - DINP);
            if (pos + 1 < L) x2[r] = *(const uint4*)(ur + DINP);
        }
#pragma unroll
        for (int r = 0; r < 2; ++r) {
            if (!okv[r]) continue;
            const int c0 = c0v[r];
            float y[8];
#pragma unroll
            for (int j = 0; j < 8; ++j) {
                const int c = c0 + j;
                y[j] = silu(cw[c] * bf2f(get16(x0[r], j)) + cw[768 + c] * bf2f(get16(x1[r], j)) + cw[1536 + c] * bf2f(get16(x2[r], j)) + cb[c]);
            }
            *(uint4*)(XBC + (size_t)tokv[r] * 768 + c0) = make_uint4(pack2(y[0], y[1]), pack2(y[2], y[3]), pack2(y[4], y[5]), pack2(y[6], y[7]));
        }
    }
}

struct PostIn { uint4 a0f, a0b, a1f, a1b, a2f, a2b, g0, g1, g2, xcv; };
__device__ __forceinline__ PostIn post_load(const u16* U, const u16* O, const u16* XBC, int tok, int c0) {
    PostIn q;
    const u16* ur = U + (size_t)tok * DINP;
    q.a0f = *(const uint4*)(O + ((size_t)0 * TT + tok) * 512 + c0); q.a0b = *(const uint4*)(O + ((size_t)1 * TT + tok) * 512 + c0);
    q.a1f = *(const uint4*)(O + ((size_t)2 * TT + tok) * 512 + c0); q.a1b = *(const uint4*)(O + ((size_t)3 * TT + tok) * 512 + c0);
    q.a2f = *(const uint4*)(O + ((size_t)4 * TT + tok) * 512 + c0); q.a2b = *(const uint4*)(O + ((size_t)5 * TT + tok) * 512 + c0);
    q.g0 = *(const uint4*)(ur + HGO + c0); q.g1 = *(const uint4*)(ur + MO + c0); q.g2 = *(const uint4*)(ur + MZ + c0);
    q.xcv = *(const uint4*)(XBC + (size_t)tok * 768 + c0);
    return q;
}
__device__ __forceinline__ void post_compute(const Params& p, int l, const PostIn& q, u16* Y, int tok, int c0) {
#pragma unroll
    for (int mx = 0; mx < 2; ++mx) {
        const uint4 af = mx ? q.a1f : q.a0f, ab = mx ? q.a1b : q.a0b, gt = mx ? q.g1 : q.g0;
        float ov[8]; float ss = 0.f;
#pragma unroll
        for (int j = 0; j < 8; ++j) { ov[j] = bf2f(get16(af, j)) + bf2f(get16(ab, j)); ss += ov[j] * ov[j]; }
#pragma unroll
        for (int o = 8; o >= 1; o >>= 1) ss += __shfl_xor(ss, o);
        const float rs = rsqrtf(ss * (1.f / 128.f) + 1e-6f);
        const float* ng = (mx == 0 ? p.in[17] : p.in[19]) + (size_t)l * 512 + c0;
        float y[8];
#pragma unroll
        for (int j = 0; j < 8; ++j) {
            float gv = bf2f(get16(gt, j));
            y[j] = ov[j] * rs * ng[j] * (mx == 0 ? silu(gv) : sigm(gv));
        }
        *(uint4*)(Y + ((size_t)mx * TT + tok) * 512 + c0) = make_uint4(pack2(y[0], y[1]), pack2(y[2], y[3]), pack2(y[4], y[5]), pack2(y[6], y[7]));
    }
    {
        const float dsk = p.in[24][l * 8 + (c0 >> 6)];
        float z[8]; float ss = 0.f;
#pragma unroll
        for (int j = 0; j < 8; ++j) {
            float xc = bf2f(get16(q.xcv, j));
            float yv = bf2f(get16(q.a2f, j)) + bf2f(get16(q.a2b, j)) + dsk * xc;
            z[j] = yv * silu(bf2f(get16(q.g2, j)));
            ss += z[j] * z[j];
        }
#pragma unroll
        for (int o = 32; o >= 1; o >>= 1) ss += __shfl_xor(ss, o);
        const float rs = rsqrtf(ss * (1.f / 512.f) + 1e-6f);
        const float* ng = p.in[25] + (size_t)l * 512 + c0;
        float y[8];
#pragma unroll
        for (int j = 0; j < 8; ++j) y[j] = z[j] * rs * ng[j];
        *(uint4*)(Y + ((size_t)2 * TT + tok) * 512 + c0) = make_uint4(pack2(y[0], y[1]), pack2(y[2], y[3]), pack2(y[4], y[5]), pack2(y[6], y[7]));
    }
}
__device__ __forceinline__ void phase_post(const Params& p, int l) {
    const u16* U = (const u16*)(p.ws + OFF_U);
    const u16* O = (const u16*)(p.ws + OFF_O);
    const u16* XBC = (const u16*)(p.ws + OFF_Z);
    u16* Y = (u16*)(p.ws + OFF_Y);
    const int tid_ = fresh_tid(); const int lane = tid_ & 63, w = tid_ >> 6;
    const int c0 = lane * 8;
    const int stride = gridDim.x * NW;
    for (int tok = fresh_bid() * NW + w; tok < TT; tok += 2 * stride) {
        const int tok2 = tok + stride;
        const bool has2 = tok2 < TT;
        const PostIn qa = post_load(U, O, XBC, tok, c0);
        const PostIn qb = post_load(U, O, XBC, has2 ? tok2 : tok, c0);
        post_compute(p, l, qa, Y, tok, c0);
        if (has2) post_compute(p, l, qb, Y, tok2, c0);
    }
}

__global__ void __launch_bounds__(NTHR, 2) fwd_megakernel(Params p0) {
    extern __shared__ __attribute__((aligned(16))) unsigned char smem[];
    cg::grid_group grid = cg::this_grid();
    volatile LAS unsigned* bst = (volatile LAS unsigned*)((LAS unsigned char*)smem + 81920 + 53248 + 2 * 144 + 128);
    if (threadIdx.x == 0) { bst[0] = 0u; bst[1] = 0u; }
    __syncthreads();
    { Params q = fresh(p0); (void)xcd_barrier_post((unsigned*)(q.ws + OFF_BAR), bst); }
    { Params p = fresh(p0); phase_mod(p, smem); }
    __syncthreads();
    { Params p = fresh(p0); convert_layer(p, 0, smem); }
    grid.sync();
    { Params p = fresh(p0); phase_xinit(p); }
    xcd_barrier(p0, smem);
#pragma unroll 1
    for (int l = 0; l < 4; ++l) {
        { Params p = fresh(p0); phase_ffn_up(p, l, 0, smem); }
        xcd_barrier(p0, smem);
        { Params p = fresh(p0); phase_gemm_resid_ln(p, l, (const u16*)(p.ws + OFF_U), (const u16*)(p.ws + OFF_WDN + (size_t)(l & 1) * WSET), DFF, 2048, 0.5f, 0, l, 3072, false, smem); }
        xcd_barrier(p0, smem);
        { Params p = fresh(p0); phase_inproj(p, l, smem); }
        xcd_barrier(p0, smem);
        { Params p = fresh(p0); phase_conv(p, l); }
        xcd_barrier(p0, smem);
        { Params p = fresh(p0); phase_scan(p, l, smem); }
        xcd_barrier(p0, smem);
        { Params p = fresh(p0); phase_post(p, l); }
        xcd_barrier(p0, smem);
        { Params p = fresh(p0); phase_branch(p, l, smem); }
        xcd_barrier(p0, smem);
        { Params p = fresh(p0); phase_gemm_resid_ln(p, l, (const u16*)(p.ws + OFF_G), (const u16*)(p.ws + OFF_WOUT + (size_t)(l & 1) * WSET), D, 5120, 1.0f, 1, l, 6144, false, smem); }
        xcd_barrier(p0, smem);
        { Params p = fresh(p0); phase_ffn_up(p, l, 1, smem); }
        xcd_barrier(p0, smem);
        { Params p = fresh(p0); phase_gemm_resid_ln(p, l, (const u16*)(p.ws + OFF_U), (const u16*)(p.ws + OFF_WDN + (size_t)(l & 1) * WSET) + (size_t)1024 * 2816, DFF, 8192, 0.5f, 2, l + 1 < 4 ? l + 1 : l, 0, l == 3, smem); }
        if (l + 1 < 4) xcd_barrier(p0, smem);
    }
}

extern "C" void kernel_launch(void* const* d_in, const int* in_sizes, int n_in, void* d_out, int out_size, void* d_ws,
                              size_t ws_size, hipStream_t stream) {
    static int grid_blocks = 0;
    if (!grid_blocks) {
        int dev = 0, cus = 0, per_cu = 0;
        hipGetDevice(&dev);
        hipDeviceGetAttribute(&cus, hipDeviceAttributeMultiprocessorCount, dev);
        hipFuncSetAttribute((const void*)fwd_megakernel, hipFuncAttributeMaxDynamicSharedMemorySize, LDS_BYTES);
        hipOccupancyMaxActiveBlocksPerMultiprocessor(&per_cu, (const void*)fwd_megakernel, NTHR, LDS_BYTES);
        if (per_cu < 1) per_cu = 1;
        if (per_cu > 1) per_cu = 1;
        grid_blocks = cus * per_cu;
        if (ws_size < WS_END) fprintf(stderr, "workspace too small: %zu < %zu\n", ws_size, (size_t)WS_END);
    }
    Params p{};
    for (int i = 0; i < 28 && i < n_in; ++i) p.in[i] = (const float*)d_in[i];
    p.out = (float*)d_out;
    p.ws = (unsigned char*)d_ws;
    hipMemsetAsync((char*)d_ws + OFF_CTR, 0, CTL_BYTES, stream);
    void* args[] = {&p};
    hipError_t e = hipLaunchCooperativeKernel((const void*)fwd_megakernel, dim3(grid_blocks), dim3(NTHR), args, LDS_BYTES, stream);
    if (e != hipSuccess) fprintf(stderr, "cooperative launch failed: %s (grid %d)\n", hipGetErrorString(e), grid_blocks);
}
```

```cpp
#include <hip/hip_runtime.h>
#include <hip/hip_cooperative_groups.h>
#include <cstdio>
namespace cg = cooperative_groups;

typedef __attribute__((ext_vector_type(8))) short bf16x8;
typedef __attribute__((ext_vector_type(4))) float f32x4;
typedef unsigned short u16;

constexpr int D = 1024, TCTX = 8192, TT = 12288, DFF = 2816, DIN = 8992, DINP = 9216;
constexpr int HQ = 0, HI = 512, HGO = 1024, HF = 1536, MQ = 2560, MK = 3072, MV = 3584, MO = 4096, MI = 4608, MF = 4616,
              MZ = 4624, MXBC = 5136, MDT = 5904, BG = 5920;
constexpr float ALPHA = 1.681792830507429f;
constexpr int NTHR = 512, NW = 8;
constexpr int LDS_BYTES = 163840;

constexpr size_t OFF_CTR = 0;
constexpr size_t OFF_BAR = 256;
constexpr size_t OFF_LNCNT = 16384;
constexpr size_t CTL_BYTES = 32768;
constexpr size_t OFF_XBUF = CTL_BYTES;
constexpr size_t OFF_WGU = OFF_XBUF + (size_t)TT * 4 * 8;
constexpr size_t OFF_WDN = OFF_WGU + (size_t)2 * 5632 * 1024 * 2;
constexpr size_t OFF_WIN = OFF_WDN + (size_t)2 * 1024 * 2816 * 2;
constexpr size_t OFF_WBR = OFF_WIN + (size_t)DINP * 1024 * 2;
constexpr size_t OFF_WOUT = OFF_WBR + (size_t)3 * 1024 * 512 * 2;
constexpr size_t WSET = OFF_WOUT + (size_t)1024 * 1024 * 2 - OFF_WGU;
constexpr size_t OFF_MOD = OFF_WGU + 2 * WSET;
constexpr size_t OFF_LBS = OFF_MOD + (size_t)4 * 5 * 9216 * 4;
constexpr size_t OFF_X = OFF_LBS + (size_t)4 * 2 * 512 * 4;
constexpr size_t OFF_Z = OFF_X + (size_t)TT * D * 4;
constexpr size_t OFF_XM = OFF_Z + (size_t)TT * D * 4;
constexpr size_t OFF_U = OFF_XM + (size_t)TT * D * 2;
constexpr size_t OFF_O = OFF_U + (size_t)TT * DINP * 2;
constexpr size_t OFF_Y = OFF_O + (size_t)6 * TT * 512 * 2;
constexpr size_t OFF_G = OFF_Y + (size_t)TT * 1536 * 2;
constexpr size_t WS_END = OFF_G + (size_t)TT * 1024 * 2;

struct Params {
    const float* in[28];
    float* out;
    unsigned char* ws;
};

__device__ __forceinline__ unsigned pack2(float a, float b) {
    unsigned r;
    asm("v_cvt_pk_bf16_f32 %0, %1, %2" : "=v"(r) : "v"(a), "v"(b));
    return r;
}
__device__ __forceinline__ u16 f2bf(float f) { return (u16)(pack2(f, 0.f) & 0xffffu); }
__device__ __forceinline__ float bf2f(u16 h) { return __uint_as_float(((unsigned)h) << 16); }
__device__ __forceinline__ float sigm(float x) { return 1.f / (1.f + __expf(-x)); }
__device__ __forceinline__ float silu(float x) { return x / (1.f + __expf(-x)); }

__device__ __forceinline__ u16 get16(const uint4& v, int e) {
    const unsigned wv = (e >> 1) == 0 ? v.x : (e >> 1) == 1 ? v.y : (e >> 1) == 2 ? v.z : v.w;
    return (u16)((e & 1) ? (wv >> 16) : (wv & 0xffffu));
}
__device__ __forceinline__ int fresh_bid() {
    int b = blockIdx.x;
    asm volatile("" : "+s"(b));
    return b;
}
__device__ __forceinline__ int fresh_tid() {
    int t = threadIdx.x;
    asm volatile("" : "+v"(t));
    return t;
}

template <int MT, int NT, bool SWA = false, bool SWB = false>
__device__ __forceinline__ void mma_nt(f32x4 (&acc)[MT][NT], const u16* A, int lda, const u16* B, int ldb, int K, int lane, int arow0 = 0, int brow0 = 0) {
    const int lr = lane & 15, lq = lane >> 4;
    for (int k0 = 0; k0 < K; k0 += 32) {
        bf16x8 a[MT], b[NT];
#pragma unroll
        for (int m = 0; m < MT; ++m) {
            const int ch = SWA ? ((((k0 >> 3) + lq) ^ (((arow0 + m * 16 + lr) >> 3) & 7)) << 3) : (k0 + lq * 8);
            a[m] = *(const bf16x8*)(A + (m * 16 + lr) * lda + ch);
        }
#pragma unroll
        for (int n = 0; n < NT; ++n) {
            const int ch = SWB ? ((((k0 >> 3) + lq) ^ (((brow0 + n * 16 + lr) >> 3) & 7)) << 3) : (k0 + lq * 8);
            b[n] = *(const bf16x8*)(B + (n * 16 + lr) * ldb + ch);
        }
#pragma unroll
        for (int m = 0; m < MT; ++m)
#pragma unroll
            for (int n = 0; n < NT; ++n) acc[m][n] = __builtin_amdgcn_mfma_f32_16x16x32_bf16(a[m], b[n], acc[m][n], 0, 0, 0);
    }
}

__device__ __forceinline__ int modset_of_row(int row) { return row < TCTX ? 0 : 1 + ((row - TCTX) >> 10); }

__device__ __forceinline__ void convert_tile(const Params& p, int l, int it, unsigned char* smem) {
    float* sm = (float*)smem;
    const int tid = fresh_tid();
    const size_t wb = (size_t)(l & 1) * WSET;
    u16* WGU = (u16*)(p.ws + OFF_WGU + wb);
    u16* WDN = (u16*)(p.ws + OFF_WDN + wb);
    u16* WIN = (u16*)(p.ws + OFF_WIN + wb);
    u16* WBR = (u16*)(p.ws + OFF_WBR + wb);
    u16* WOUT = (u16*)(p.ws + OFF_WOUT + wb);
    {
        const float* src;
        u16* dst;
        int K, N, tn, mode = 0, t = it;
        if (t < 704) {
            int i = t / 352; t -= i * 352;
            src = p.in[13] + ((size_t)(l * 2 + i)) * 1024 * 5632; dst = WGU + (size_t)i * 5632 * 1024; K = 1024; N = 5632; tn = 22; mode = 1;
        } else if (t < 704 + 352) {
            t -= 704; int i = t / 176; t -= i * 176;
            src = p.in[14] + ((size_t)(l * 2 + i)) * 2816 * 1024; dst = WDN + (size_t)i * 1024 * 2816; K = 2816; N = 1024; tn = 4;
        } else if (t < 1056 + 576) {
            t -= 1056;
            src = p.in[15] + (size_t)l * 1024 * DIN; dst = WIN; K = 1024; N = DIN; tn = 36;
        } else if (t < 1632 + 96) {
            t -= 1632; int c = t / 32; t -= c * 32;
            src = p.in[26] + ((size_t)(l * 3 + c)) * 512 * 1024; dst = WBR + (size_t)c * 1024 * 512; K = 512; N = 1024; tn = 4;
        } else {
            t -= 1728;
            src = p.in[27] + (size_t)l * 1024 * 1024; dst = WOUT; K = 1024; N = 1024; tn = 4;
        }
        const int kt = t / tn, ntl = t - kt * tn;
        const int k0 = kt * 64, n0 = ntl * 256;
        float4 v[8];
#pragma unroll
        for (int ps = 0; ps < 8; ++ps) {
            const int kr = ps * 8 + (tid >> 6), c4 = (tid & 63) * 4;
            v[ps] = make_float4(0.f, 0.f, 0.f, 0.f);
            if (n0 + c4 < N) v[ps] = *(const float4*)(src + (size_t)(k0 + kr) * N + n0 + c4);
        }
#pragma unroll
        for (int ps = 0; ps < 8; ++ps) {
            const int kr = ps * 8 + (tid >> 6), c4 = (tid & 63) * 4;
            sm[kr * 257 + c4 + 0] = v[ps].x; sm[kr * 257 + c4 + 1] = v[ps].y; sm[kr * 257 + c4 + 2] = v[ps].z; sm[kr * 257 + c4 + 3] = v[ps].w;
        }
        __syncthreads();
        {
            const int nl = tid >> 1, ks = (tid & 1) * 32;
            int n = n0 + nl, nd = n;
            if (mode == 1) {
                int part = n >= 2816 ? 1 : 0;
                int nn = n - part * 2816;
                nd = (nn >> 7) * 256 + part * 128 + (nn & 127);
            }
            u16* dp = dst + (size_t)nd * K + k0 + ks;
#pragma unroll
            for (int q = 0; q < 4; ++q) {
                unsigned pk[4];
#pragma unroll
                for (int j = 0; j < 4; ++j) pk[j] = pack2(sm[(ks + q * 8 + 2 * j) * 257 + nl], sm[(ks + q * 8 + 2 * j + 1) * 257 + nl]);
                *(uint4*)(dp + q * 8) = make_uint4(pk[0], pk[1], pk[2], pk[3]);
            }
        }
        __syncthreads();
    }
}

constexpr int CONV_TILES = (1408 * 2 + 704 * 2 + 2304 + 128 * 3 + 256) / 4;
__device__ __forceinline__ void convert_layer(const Params& p, int l, unsigned char* smem) {
    for (int it = fresh_bid(); it < CONV_TILES; it += gridDim.x) convert_tile(p, l, it, smem);
}

__device__ __forceinline__ void phase_mod(const Params& p, unsigned char* smem) {
    float* sc = (float*)smem;
    float* red = sc + 5 * 1024;
    const int tid = fresh_tid();
    for (int i = tid; i < 5 * 1024; i += NTHR) {
        int j = i >> 10, d = i & 1023;
        float v = (j == 0) ? p.in[8][d] : p.in[7][(j - 1) * 1024 + d];
        sc[i] = silu(v);
    }
    __syncthreads();
    float* MOD = (float*)(p.ws + OFF_MOD);
    const int col = tid & 63, q = tid >> 6;
    for (int it = fresh_bid(); it < 4 * 144; it += gridDim.x) {
        const int l = it / 144, e = (it % 144) * 64 + col;
        const float* wp = p.in[9] + (size_t)l * 1024 * 9216 + e;
        float a0 = 0, a1 = 0, a2 = 0, a3 = 0, a4 = 0;
#pragma unroll 32
        for (int d = q * 128; d < q * 128 + 128; ++d) {
            float wv = wp[(size_t)d * 9216];
            a0 += sc[d] * wv; a1 += sc[1024 + d] * wv; a2 += sc[2048 + d] * wv; a3 += sc[3072 + d] * wv; a4 += sc[4096 + d] * wv;
        }
        red[(q * 5 + 0) * 64 + col] = a0; red[(q * 5 + 1) * 64 + col] = a1; red[(q * 5 + 2) * 64 + col] = a2;
        red[(q * 5 + 3) * 64 + col] = a3; red[(q * 5 + 4) * 64 + col] = a4;
        __syncthreads();
        for (int i = tid; i < 5 * 64; i += NTHR) {
            int j = i >> 6, cc = i & 63;
            float s = 0.f;
            for (int qq = 0; qq < 8; ++qq) s += red[(qq * 5 + j) * 64 + cc];
            int ee = (it % 144) * 64 + cc;
            MOD[((size_t)l * 5 + j) * 9216 + ee] = s + p.in[10][l * 9216 + ee];
        }
        __syncthreads();
    }
    float* LBS = (float*)(p.ws + OFF_LBS);
    for (int i = fresh_bid() * NTHR + tid; i < 1024; i += gridDim.x * NTHR) {
        float v0 = p.in[16][i], v1 = p.in[16][1024 + i], v2 = p.in[16][2048 + i], v3 = p.in[16][3072 + i];
        float mx = fmaxf(fmaxf(v0, v1), fmaxf(v2, v3));
        float e0 = expf(v0 - mx), e1 = expf(v1 - mx), e2 = expf(v2 - mx), e3 = expf(v3 - mx);
        float inv = 1.f / (e0 + e1 + e2 + e3);
        LBS[i] = 0.f; LBS[1024 + i] = e1 * inv; LBS[2048 + i] = (e1 + e2) * inv; LBS[3072 + i] = (e1 + e2 + e3) * inv;
    }
}

__device__ __forceinline__ void phase_xinit(const Params& p) {
    u16* X = (u16*)(p.ws + OFF_X);
    u16* XM = (u16*)(p.ws + OFF_XM);
    const float* MOD = (const float*)(p.ws + OFF_MOD);
    const int tid = fresh_tid();
    for (size_t i4 = (size_t)fresh_bid() * NTHR + tid; i4 < (size_t)TT * D / 4; i4 += (size_t)gridDim.x * NTHR) {
        const int row = (int)(i4 >> 8), c0 = (int)(i4 & 255) * 4;
        float v[4];
        if (row < TCTX) {
            float4 t = *(const float4*)(p.in[0] + (size_t)row * D + c0);
            v[0] = t.x; v[1] = t.y; v[2] = t.z; v[3] = t.w;
        } else {
            float4 t = *(const float4*)(p.in[1] + (size_t)(row - TCTX) * D + c0);
            v[0] = t.x; v[1] = t.y; v[2] = t.z; v[3] = t.w;
            const int tk = (row - TCTX) & 1023;
            const float rr = (float)(tk >> 6), cc = (float)(tk & 63);
#pragma unroll
            for (int j = 0; j < 4; ++j) {
                int d = c0 + j, qd = d >> 8, fi = d & 255;
                float freq = expf(-9.210340371976184f * (float)fi / 256.f);
                float ang = ((qd < 2) ? rr : cc) * freq;
                v[j] += (qd & 1) ? cosf(ang) : sinf(ang);
            }
        }
        *(uint2*)(X + (size_t)row * D + c0) = make_uint2(pack2(v[0], v[1]), pack2(v[2], v[3]));
        const float* md = MOD + (size_t)(0 * 5 + modset_of_row(row)) * 9216;
        float m[4];
#pragma unroll
        for (int j = 0; j < 4; ++j) m[j] = v[j] * (1.f + md[1024 + c0 + j]) + md[c0 + j];
        *(uint2*)(XM + (size_t)row * D + c0) = make_uint2(pack2(m[0], m[1]), pack2(m[2], m[3]));
    }
}

__device__ __forceinline__ Params fresh(const Params& p0) {
#if defined(__HIP_DEVICE_COMPILE__)
    typedef const __attribute__((address_space(4))) Params* KP;
    KP kp = (KP)__builtin_amdgcn_kernarg_segment_ptr();
    asm volatile("" : "+s"(kp));
    Params q;
#pragma unroll
    for (int i = 0; i < 28; ++i) q.in[i] = kp->in[i];
    q.out = kp->out; q.ws = kp->ws;
    return q;
#else
    return p0;
#endif
}
#define XB_TMO      128
#define XB_XCNT(j)  (256  + 64 * (j))
#define XB_XSUB(j)  (1280 + 64 * (j))
#define XB_XGEN(j)  (2304 + 64 * (j))
#define XB_TOP      3328
#define XB_TOPGEN   3392
#define XCD_BAR_WORDS 3456
#define XB_SPIN_CAP (1u << 18)
#define LAS __attribute__((address_space(3)))
__device__ __forceinline__ unsigned xb_ld(unsigned* p)              { return __hip_atomic_load(p, __ATOMIC_RELAXED, __HIP_MEMORY_SCOPE_AGENT); }
__device__ __forceinline__ unsigned xb_add(unsigned* p, unsigned v) { return __hip_atomic_fetch_add(p, v, __ATOMIC_RELAXED, __HIP_MEMORY_SCOPE_AGENT); }
__device__ __forceinline__ unsigned xb_xcc_id() { return (unsigned)__builtin_amdgcn_s_getreg((3 << 11) | 20) & 0xFu; }
#define XB_SPIN(cond, bar) do { unsigned _sp = 0; while (cond) { __builtin_amdgcn_s_sleep(1); \
    if ((++_sp & 255u) == 0u) { if (xb_ld(&(bar)[XB_TMO])) break; if (_sp > XB_SPIN_CAP) { atomicAdd(&(bar)[XB_TMO], 1u); break; } } } } while (0)
struct XcdBarrier { unsigned* bar; unsigned x; volatile LAS unsigned* st; };
__device__ __forceinline__ XcdBarrier xcd_barrier_post(unsigned* bar, volatile LAS unsigned* st) {
    XcdBarrier b; b.bar = bar; b.x = xb_xcc_id(); b.st = st;
    if (threadIdx.x == 0) (void)xb_add(&bar[XB_XCNT(b.x)], 1u);
    return b;
}
__device__ __forceinline__ void xcd_barrier_complete(unsigned* bar, unsigned x, unsigned& nloc, unsigned& nx) {
    const unsigned G = gridDim.x * gridDim.y * gridDim.z;
    unsigned sum, cnt, mine, sp = 0u;
    for (;;) {
        sum = 0u; cnt = 0u; mine = 0u;
#pragma unroll
        for (unsigned j = 0; j < 16; ++j) { const unsigned c = xb_ld(&bar[XB_XCNT(j)]); sum += c; cnt += (c > 0u) ? 1u : 0u; mine = (j == x) ? c : mine; }
        if (sum == G) break;
        __builtin_amdgcn_s_sleep(1);
        if ((++sp & 255u) == 0u) { if (xb_ld(&bar[XB_TMO])) break; if (sp > XB_SPIN_CAP) { atomicAdd(&bar[XB_TMO], 1u); break; } }
    }
    nloc = mine > 0u ? mine : 1u; nx = cnt > 0u ? cnt : 1u;
}
__device__ __forceinline__ void xcd_barrier_(const XcdBarrier& b) {
    asm volatile("s_waitcnt vmcnt(0)" ::: "memory");
    __syncthreads();
    if (fresh_tid() == 0) {
        unsigned* bar = b.bar;
        __builtin_amdgcn_s_waitcnt(0);
        unsigned nloc = b.st[0], nx = b.st[1];
        if (nloc == 0u) { xcd_barrier_complete(bar, b.x, nloc, nx); b.st[0] = nloc; b.st[1] = nx; }
        const unsigned old = xb_add(&bar[XB_XSUB(b.x)], 1u);
        const unsigned gen = old / nloc;
        if (old + 1u == (gen + 1u) * nloc) {
            __builtin_amdgcn_fence(__ATOMIC_RELEASE, "agent");
            asm volatile("s_waitcnt vmcnt(0)" ::: "memory");
            const unsigned og = xb_add(&bar[XB_TOP], 1u);
            const unsigned tg = og / nx;
            if (og + 1u == (tg + 1u) * nx) xb_add(&bar[XB_TOPGEN], 1u);
            else XB_SPIN(xb_ld(&bar[XB_TOPGEN]) == tg, bar);
            __builtin_amdgcn_fence(__ATOMIC_ACQUIRE, "agent");
            xb_add(&bar[XB_XGEN(b.x)], 1u);
            asm volatile("s_waitcnt vmcnt(0)" ::: "memory");
        } else {
            XB_SPIN(xb_ld(&bar[XB_XGEN(b.x)]) == gen, bar);
            __builtin_amdgcn_fence(__ATOMIC_ACQUIRE, "agent");
            asm volatile("s_waitcnt vmcnt(0)" ::: "memory");
        }
    }
    __syncthreads();
}

__device__ __forceinline__ void xcd_barrier(const Params& p0, unsigned char* smem) {
    Params q = fresh(p0);
    XcdBarrier b; b.bar = (unsigned*)(q.ws + OFF_BAR); b.x = xb_xcc_id();
    b.st = (volatile LAS unsigned*)((LAS unsigned char*)smem + 81920 + 53248 + 2 * 144 + 128);
    xcd_barrier_(b);
}

namespace pg8 {
constexpr int BM = 256, BK = 64, HALF = 128, HTB = HALF * BK * 2, STAGE_BYTES = 8 * HTB, NXCD = 8, WGM = 8;
__device__ __forceinline__ int lds_byte(int r, int c) { const int st = (r >> 4) * 2 + (c >> 5), rr = r & 15, cc = c & 31, ob = rr * 64 + cc * 2; return st * 1024 + (ob ^ (((ob >> 9) & 1) << 5)); }
__device__ __forceinline__ void stage_rc(int b, int& R, int& C) { const int st = b / 1024, sb = b % 1024, swz = sb ^ (((sb >> 9) & 1) << 5); R = (st >> 1) * 16 + swz / 64; C = (st & 1) * 32 + (swz % 64) / 2; }
__device__ __forceinline__ int perm32(int rho) { const int n = rho >> 4, i = rho & 15; return 8 * (i >> 2) + 4 * n + (i & 3); }
struct Unit { int pm, pn; };
struct Gemm { const u16* A; const u16* Bt; int K; };
struct Sched {
    int nM, nN, nwg, G, c, br;
    __device__ __forceinline__ void init(int nM_, int nN_, int G_, int c_, int br_) { nM = nM_; nN = nN_; nwg = nM * nN; G = G_; c = c_; br = br_; }
    __device__ __forceinline__ bool next(int i, Unit& u) const {
        const int round = br ? i / 3 : i, cc = br ? i - round * 3 : 0;
        const long L = (long)round * G + c; if (L >= nwg) return false;
        int wgid = (int)L; { const int q = nwg / NXCD, r = nwg % NXCD, xcd = wgid % NXCD, off = wgid / NXCD; wgid = (xcd < r ? xcd * (q + 1) : r * (q + 1) + (xcd - r) * q) + off; }
        const int nig = WGM * nN, gid = wgid / nig, fm = gid * WGM, gsz = (nM - fm) < WGM ? (nM - fm) : WGM;
        u.pm = fm + ((wgid % nig) % gsz) + cc * nM; u.pn = (wgid % nig) / gsz + cc * nN; return true;
    }
};
template <class Epi>
__device__ __forceinline__ void gemm_phase(LAS unsigned char* lds, const Gemm g, const Sched& S, const Epi& E) {
    const int tid = fresh_tid(), wid = __builtin_amdgcn_readfirstlane(tid >> 6), lane = tid & 63, wr = wid >> 2, wc = wid & 3, fr = lane & 15, fq = lane >> 4;
    const int K = g.K, nt = K / BK;
    unsigned voffA[2], voffB[2];
#pragma unroll
    for (int i = 0; i < 2; ++i) { int R, C; stage_rc(tid * 16 + i * 8192, R, C); const int Rb = Epi::PERM ? ((R & ~31) + perm32(R & 31)) : R;
        voffA[i] = (unsigned)(R * K + C) * 2u; voffB[i] = (unsigned)(Rb * K + C) * 2u; }
    const size_t kstep = (size_t)(BK * 2);
    const size_t hstep = (size_t)HALF * K * 2;
    const size_t tstep = 2 * hstep;
    const unsigned ldsw = (unsigned)wid * 1024u;
    const int aoff = lds_byte(wr * 64 + fr, fq * 8), boff = lds_byte(wc * 32 + fr, fq * 8);
#define PG8_SA(b, h) (((b) * 2 + (h)) * HTB)
#define PG8_SB(b, h) ((4 + (b) * 2 + (h)) * HTB)
#define PG8_STAGE(bufoff, gbase, voff) do { _Pragma("unroll") for (int _i = 0; _i < 2; ++_i) \
        __builtin_amdgcn_global_load_lds((const unsigned*)((const char*)(gbase) + (voff)[_i]), (LAS unsigned*)(lds + (bufoff) + ldsw + _i * 8192), 16, 0, 0); } while (0)
#define PG8_LDA(dst, b, h) do { _Pragma("unroll") for (int m = 0; m < 4; ++m) _Pragma("unroll") for (int k = 0; k < 2; ++k) dst[m][k] = *(const LAS bf16x8*)(lds + PG8_SA(b, h) + aoff + m * 2048 + k * 1024); } while (0)
#define PG8_LDB(dst, b, h) do { _Pragma("unroll") for (int n = 0; n < 2; ++n) _Pragma("unroll") for (int k = 0; k < 2; ++k) dst[n][k] = *(const LAS bf16x8*)(lds + PG8_SB(b, h) + boff + n * 2048 + k * 1024); } while (0)
#define PG8_MMA(ai, bj, At, Bt) do { __builtin_amdgcn_s_setprio(1); _Pragma("unroll") for (int m = 0; m < 4; ++m) _Pragma("unroll") for (int n = 0; n < 2; ++n) _Pragma("unroll") for (int k = 0; k < 2; ++k) \
        acc[ai][bj][m][n] = __builtin_amdgcn_mfma_f32_16x16x32_bf16(Bt[n][k], At[m][k], acc[ai][bj][m][n], 0, 0, 0); __builtin_amdgcn_s_setprio(0); } while (0)
#define PG8_WAIT_V(n) asm volatile("s_waitcnt vmcnt(" #n ")" ::: "memory")
#define PG8_WAIT_L(n) asm volatile("s_waitcnt lgkmcnt(" #n ")" ::: "memory")
#define PG8_BAR __builtin_amdgcn_s_barrier()
#define PG8_SCHED __builtin_amdgcn_sched_barrier(0)
    Unit cur, nxt; int ui = 0;
    if (!S.next(0, cur)) return;
    f32x4 acc[2][2][4][2];
#pragma unroll
    for (int a = 0; a < 2; ++a)
#pragma unroll
        for (int b = 0; b < 2; ++b)
#pragma unroll
            for (int m = 0; m < 4; ++m)
#pragma unroll
                for (int n = 0; n < 2; ++n) acc[a][b][m][n] = (f32x4){0.f, 0.f, 0.f, 0.f};
    bf16x8 At[4][2], B0[2][2], B1[2][2];
    const char* cA = (const char*)g.A + (size_t)cur.pm * tstep; const char* cB = (const char*)g.Bt + (size_t)cur.pn * tstep;
    PG8_STAGE(PG8_SB(0, 0), cB, voffB); PG8_STAGE(PG8_SA(0, 0), cA, voffA); PG8_STAGE(PG8_SB(0, 1), cB + hstep, voffB); PG8_STAGE(PG8_SA(0, 1), cA + hstep, voffA);
    if (wr == 1) PG8_BAR;
    PG8_WAIT_V(4); PG8_BAR;
    PG8_STAGE(PG8_SB(1, 0), cB + kstep, voffB); PG8_STAGE(PG8_SA(1, 0), cA + kstep, voffA); PG8_STAGE(PG8_SB(1, 1), cB + hstep + kstep, voffB);
    PG8_WAIT_V(6); PG8_BAR;
    for (;;) {
        const bool has_next = S.next(ui + 1, nxt);
        const char* nA = has_next ? (const char*)g.A + (size_t)nxt.pm * tstep : cA; const char* nB = has_next ? (const char*)g.Bt + (size_t)nxt.pn * tstep : cB;
        for (int t = 0; t < nt; t += 2) {
            const bool last = (t == nt - 2);
            const char* a1 = cA + (size_t)(t + 1) * kstep;
            const char* a2 = last ? nA : cA + (size_t)(t + 2) * kstep; const char* b2 = last ? nB : cB + (size_t)(t + 2) * kstep;
            const char* a3 = a2 + kstep; const char* b3 = b2 + kstep;
            PG8_LDB(B0, 0, 0); PG8_SCHED; PG8_LDA(At, 0, 0); PG8_STAGE(PG8_SA(1, 1), a1 + hstep, voffA);
            PG8_WAIT_L(8); PG8_BAR; PG8_WAIT_L(0); PG8_MMA(0, 0, At, B0); PG8_BAR; PG8_SCHED;
            PG8_LDB(B1, 0, 1); PG8_STAGE(PG8_SB(0, 0), b2, voffB);
            PG8_BAR; PG8_WAIT_L(0); PG8_MMA(0, 1, At, B1); PG8_BAR;
            PG8_LDA(At, 0, 1); PG8_STAGE(PG8_SA(0, 0), a2, voffA);
            PG8_BAR; PG8_WAIT_L(0); PG8_MMA(1, 0, At, B0); PG8_BAR; PG8_SCHED;
            PG8_STAGE(PG8_SB(0, 1), b2 + hstep, voffB);
            PG8_WAIT_V(6); PG8_BAR; PG8_MMA(1, 1, At, B1); PG8_BAR;
            PG8_LDB(B0, 1, 0); PG8_SCHED; PG8_LDA(At, 1, 0); PG8_STAGE(PG8_SA(0, 1), a2 + hstep, voffA);
            PG8_WAIT_L(8); PG8_BAR; PG8_WAIT_L(0); PG8_MMA(0, 0, At, B0); PG8_BAR; PG8_SCHED;
            PG8_LDB(B1, 1, 1); PG8_STAGE(PG8_SB(1, 0), b3, voffB);
            PG8_BAR; PG8_WAIT_L(0); PG8_MMA(0, 1, At, B1); PG8_BAR;
            PG8_LDA(At, 1, 1); PG8_STAGE(PG8_SA(1, 0), a3, voffA);
            PG8_BAR; PG8_WAIT_L(0); PG8_MMA(1, 0, At, B0); PG8_BAR; PG8_SCHED;
            PG8_STAGE(PG8_SB(1, 1), b3 + hstep, voffB);
            PG8_WAIT_V(6); PG8_BAR; PG8_MMA(1, 1, At, B1); PG8_BAR;
        }
        if constexpr (!Epi::AFTER_DRAIN) E(acc, cur, wr, wc, fr, fq);
        if (!has_next) break;
#pragma unroll
        for (int a = 0; a < 2; ++a)
#pragma unroll
            for (int b = 0; b < 2; ++b)
#pragma unroll
                for (int m = 0; m < 4; ++m)
#pragma unroll
                    for (int n = 0; n < 2; ++n) acc[a][b][m][n] = (f32x4){0.f, 0.f, 0.f, 0.f};
        cur = nxt; cA = nA; cB = nB; ++ui;
    }
    PG8_WAIT_V(0);
    if (wr == 0) PG8_BAR;
    PG8_BAR;
    if constexpr (Epi::AFTER_DRAIN) E.fused(acc, cur, wr, wc, fr, fq, lds, wid, lane);
#undef PG8_SA
#undef PG8_SB
#undef PG8_STAGE
#undef PG8_LDA
#undef PG8_LDB
#undef PG8_MMA
#undef PG8_WAIT_V
#undef PG8_WAIT_L
#undef PG8_BAR
#undef PG8_SCHED
}
}

struct EpiSwiglu {
    static constexpr bool PERM = true;
    static constexpr bool AFTER_DRAIN = false;
    u16* H;
    __device__ __forceinline__ void operator()(const f32x4 (&acc)[2][2][4][2], const pg8::Unit& u, int wr, int wc, int fr, int fq) const {
        const int f = u.pn * 128 + wc * 32 + fq * 8;
#pragma unroll
        for (int ai = 0; ai < 2; ++ai)
#pragma unroll
            for (int m = 0; m < 4; ++m) {
                const int row = u.pm * 256 + ai * 128 + wr * 64 + m * 16 + fr;
                const f32x4 a0 = acc[ai][0][m][0], a1 = acc[ai][0][m][1], b0 = acc[ai][1][m][0], b1 = acc[ai][1][m][1];
                *(uint4*)(H + (size_t)row * DFF + f) = make_uint4(pack2(silu(a0[0]) * b0[0], silu(a0[1]) * b0[1]), pack2(silu(a0[2]) * b0[2], silu(a0[3]) * b0[3]),
                                                                  pack2(silu(a1[0]) * b1[0], silu(a1[1]) * b1[1]), pack2(silu(a1[2]) * b1[2], silu(a1[3]) * b1[3]));
            }
    }
};
struct EpiU {
    static constexpr bool PERM = true;
    static constexpr bool AFTER_DRAIN = false;
    u16* U; const float* LBSL;
    __device__ __forceinline__ void operator()(const f32x4 (&acc)[2][2][4][2], const pg8::Unit& u, int wr, int wc, int fr, int fq) const {
        const int mode = (u.pn < 2) ? 1 : ((u.pn >= 6 && u.pn < 10) ? 2 : 0);
#pragma unroll
        for (int bj = 0; bj < 2; ++bj) {
            const int col = u.pn * 256 + bj * 128 + wc * 32 + fq * 8;
            float4 lb0 = make_float4(0.f, 0.f, 0.f, 0.f), lb1 = lb0;
            if (mode == 2) { lb0 = *(const float4*)(LBSL + (col - HF)); lb1 = *(const float4*)(LBSL + (col + 4 - HF)); }
#pragma unroll
            for (int ai = 0; ai < 2; ++ai)
#pragma unroll
                for (int m = 0; m < 4; ++m) {
                    const int row = u.pm * 256 + ai * 128 + wr * 64 + m * 16 + fr;
                    f32x4 a = acc[ai][bj][m][0], b = acc[ai][bj][m][1];
                    if (mode == 1) {
                        a[0] = silu(a[0]); a[1] = silu(a[1]); a[2] = silu(a[2]); a[3] = silu(a[3]);
                        b[0] = silu(b[0]); b[1] = silu(b[1]); b[2] = silu(b[2]); b[3] = silu(b[3]);
                    }
                    if (mode == 2) {
                        a[0] = __logf(lb0.x + (1.f - lb0.x) * sigm(a[0])); a[1] = __logf(lb0.y + (1.f - lb0.y) * sigm(a[1]));
                        a[2] = __logf(lb0.z + (1.f - lb0.z) * sigm(a[2])); a[3] = __logf(lb0.w + (1.f - lb0.w) * sigm(a[3]));
                        b[0] = __logf(lb1.x + (1.f - lb1.x) * sigm(b[0])); b[1] = __logf(lb1.y + (1.f - lb1.y) * sigm(b[1]));
                        b[2] = __logf(lb1.z + (1.f - lb1.z) * sigm(b[2])); b[3] = __logf(lb1.w + (1.f - lb1.w) * sigm(b[3]));
                    }
                    *(uint4*)(U + (size_t)row * DINP + col) = make_uint4(pack2(a[0], a[1]), pack2(a[2], a[3]), pack2(b[0], b[1]), pack2(b[2], b[3]));
                }
        }
    }
};
struct EpiBranch {
    static constexpr bool PERM = true;
    static constexpr bool AFTER_DRAIN = false;
    const u16* U; u16* Zs; u16* G;
    __device__ __forceinline__ void operator()(const f32x4 (&acc)[2][2][4][2], const pg8::Unit& u, int wr, int wc, int fr, int fq) const {
        const int c = u.pm / 48, mt = u.pm - c * 48, nt = u.pn - c * 4;
#pragma unroll
        for (int ai = 0; ai < 2; ++ai)
#pragma unroll
            for (int m = 0; m < 4; ++m) {
                const int row = mt * 256 + ai * 128 + wr * 64 + m * 16 + fr;
#pragma unroll
                for (int bj = 0; bj < 2; ++bj) {
                    const int col = nt * 256 + bj * 128 + wc * 32 + fq * 8;
                    const uint4 gr = *(const uint4*)(U + (size_t)row * DINP + BG + c * 1024 + col);
                    const f32x4 a = acc[ai][bj][m][0], b = acc[ai][bj][m][1];
                    float v[8];
                    v[0] = sigm(bf2f(get16(gr, 0))) * a[0]; v[1] = sigm(bf2f(get16(gr, 1))) * a[1];
                    v[2] = sigm(bf2f(get16(gr, 2))) * a[2]; v[3] = sigm(bf2f(get16(gr, 3))) * a[3];
                    v[4] = sigm(bf2f(get16(gr, 4))) * b[0]; v[5] = sigm(bf2f(get16(gr, 5))) * b[1];
                    v[6] = sigm(bf2f(get16(gr, 6))) * b[2]; v[7] = sigm(bf2f(get16(gr, 7))) * b[3];
                    const size_t o = (size_t)row * D + col;
                    if (c > 0) {
                        const uint4 z = *(const uint4*)(Zs + o);
#pragma unroll
                        for (int e = 0; e < 8; ++e) v[e] += bf2f(get16(z, e));
                    }
                    *(uint4*)((c < 2 ? Zs : G) + o) = make_uint4(pack2(v[0], v[1]), pack2(v[2], v[3]), pack2(v[4], v[5]), pack2(v[6], v[7]));
                }
                asm volatile("" ::: "memory");
            }
    }
};

struct EpiResidLn {
    static constexpr bool PERM = true;
    static constexpr bool AFTER_DRAIN = true;
    u16* X; float* outp; u16* XM; const float* MODG; int goff; float gs;
    const float* lng; const float* lnb; const float* MODN; int shoff; int has_xm;
    unsigned long long* xbuf; unsigned* cnt; unsigned want;
    __device__ __forceinline__ void fused(f32x4 (&acc)[2][2][4][2], const pg8::Unit& u0, int wr, int wc, int fr, int fq, LAS unsigned char* lds, int wid, int lane) const {
        typedef float f32x2v __attribute__((ext_vector_type(2)));
        pg8::Unit u = u0;
        asm volatile("" : "+s"(u.pm), "+s"(u.pn), "+s"(wr), "+s"(wc), "+s"(wid));
        asm volatile("" : "+v"(fr), "+v"(fq), "+v"(lane));
        LAS f32x2v* P = (LAS f32x2v*)lds;
        LAS f32x2v* S = (LAS f32x2v*)(lds + 8192);
        const int ms = modset_of_row(u.pm * 256);
        {
            const float* md = MODG + (size_t)ms * 9216 + goff + u.pn * 256 + wc * 32 + fq * 8;
#pragma unroll
            for (int bj = 0; bj < 2; ++bj) {
                const float4 g0 = *(const float4*)(md + bj * 128), g1 = *(const float4*)(md + bj * 128 + 4);
                size_t xo = (size_t)(u.pm * 256 + wr * 64 + fr) * D + u.pn * 256 + wc * 32 + fq * 8 + bj * 128;
                asm volatile("" : "+v"(xo));
#pragma unroll
                for (int ai = 0; ai < 2; ++ai) {
#pragma unroll
                    for (int m = 0; m < 4; ++m) {
                        const uint4 xr_ = *(const uint4*)(X + xo);
                        f32x4 a = acc[ai][bj][m][0], b = acc[ai][bj][m][1];
                        a[0] = ALPHA * bf2f(get16(xr_, 0)) + gs * g0.x * a[0]; a[1] = ALPHA * bf2f(get16(xr_, 1)) + gs * g0.y * a[1];
                        a[2] = ALPHA * bf2f(get16(xr_, 2)) + gs * g0.z * a[2]; a[3] = ALPHA * bf2f(get16(xr_, 3)) + gs * g0.w * a[3];
                        b[0] = ALPHA * bf2f(get16(xr_, 4)) + gs * g1.x * b[0]; b[1] = ALPHA * bf2f(get16(xr_, 5)) + gs * g1.y * b[1];
                        b[2] = ALPHA * bf2f(get16(xr_, 6)) + gs * g1.z * b[2]; b[3] = ALPHA * bf2f(get16(xr_, 7)) + gs * g1.w * b[3];
                        acc[ai][bj][m][0] = a; acc[ai][bj][m][1] = b;
                        asm volatile("" : "+v"(acc[ai][bj][m][0]), "+v"(acc[ai][bj][m][1]));
                        xo += 16 * D;
                        if (m & 1) asm volatile("" : "+v"(xo) :: "memory");
                    }
                    xo += 64 * D;
                }
            }
        }
#pragma unroll
        for (int ai = 0; ai < 2; ++ai)
#pragma unroll
            for (int m = 0; m < 4; ++m) {
                float s = 0.f;
#pragma unroll
                for (int bj = 0; bj < 2; ++bj)
#pragma unroll
                    for (int n = 0; n < 2; ++n) { const f32x4 x = acc[ai][bj][m][n]; s += (x[0] + x[1]) + (x[2] + x[3]); }
                s += __shfl_xor(s, 16); s += __shfl_xor(s, 32);
                const float mw = s * (1.0f / 64.0f); float q = 0.f;
#pragma unroll
                for (int bj = 0; bj < 2; ++bj)
#pragma unroll
                    for (int n = 0; n < 2; ++n) { const f32x4 d = acc[ai][bj][m][n] - mw; q += (d[0] * d[0] + d[1] * d[1]) + (d[2] * d[2] + d[3] * d[3]); }
                q += __shfl_xor(q, 16); q += __shfl_xor(q, 32);
                if (fq == 0) P[(ai * 128 + wr * 64 + m * 16 + fr) * 4 + wc] = (f32x2v){mw, q};
            }
        asm volatile("s_waitcnt lgkmcnt(0)" ::: "memory"); __builtin_amdgcn_s_barrier(); asm volatile("" ::: "memory");
        const int row = wid * 32 + (lane & 31);
        if (lane < 32) {
            const f32x2v a = P[row * 4 + 0], b = P[row * 4 + 1], c = P[row * 4 + 2], d = P[row * 4 + 3];
            const float mt = (a.x + b.x + c.x + d.x) * 0.25f;
            const float da = a.x - mt, db = b.x - mt, dc = c.x - mt, dd = d.x - mt;
            const float m2 = (a.y + b.y) + (c.y + d.y) + 64.0f * ((da * da + db * db) + (dc * dc + dd * dd));
            unsigned long long* slot = xbuf + ((size_t)(u.pm * 256 + row) * 4 + u.pn);
            __hip_atomic_store(slot, ((unsigned long long)__float_as_uint(m2) << 32) | __float_as_uint(mt), __ATOMIC_RELAXED, __HIP_MEMORY_SCOPE_AGENT);
        }
        asm volatile("s_waitcnt vmcnt(0)" ::: "memory");
        if (lane == 0) __hip_atomic_fetch_add(cnt + 64 * u.pm, 1u, __ATOMIC_RELAXED, __HIP_MEMORY_SCOPE_AGENT);
        if (wid == 0) {
            unsigned sp = 0;
            for (;;) {
                if ((unsigned)__builtin_amdgcn_readfirstlane(__hip_atomic_load(cnt + 64 * u.pm, __ATOMIC_RELAXED, __HIP_MEMORY_SCOPE_AGENT)) >= want) break;
                if (++sp > (1u << 22)) break;
                __builtin_amdgcn_s_sleep(2);
            }
            __builtin_amdgcn_fence(__ATOMIC_ACQUIRE, "agent");
        }
        asm volatile("s_waitcnt vmcnt(0) lgkmcnt(0)" ::: "memory"); __builtin_amdgcn_s_barrier(); asm volatile("" ::: "memory");
        if (lane < 32) {
            const unsigned long long* slot = xbuf + (size_t)(u.pm * 256 + row) * 4; float mt[4], m2[4]; float msum = 0.f;
#pragma unroll
            for (int t = 0; t < 4; ++t) { const unsigned long long w = __hip_atomic_load(slot + t, __ATOMIC_RELAXED, __HIP_MEMORY_SCOPE_AGENT); mt[t] = __uint_as_float((unsigned)w); m2[t] = __uint_as_float((unsigned)(w >> 32)); msum += mt[t]; }
            const float mean = msum * 0.25f; float q = 0.f;
#pragma unroll
            for (int t = 0; t < 4; ++t) { const float dm = mt[t] - mean; q += m2[t] + 256.0f * dm * dm; }
            S[row] = (f32x2v){mean, 1.0f / sqrtf(q * (1.0f / 1024.0f) + 1e-5f)};
        }
        asm volatile("s_waitcnt lgkmcnt(0)" ::: "memory"); __builtin_amdgcn_s_barrier(); asm volatile("" ::: "memory");
        asm volatile("" : "+s"(u.pm), "+s"(u.pn), "+s"(wr), "+s"(wc));
        asm volatile("" : "+v"(fr), "+v"(fq));
        {
            const int cb0 = u.pn * 256 + wc * 32 + fq * 8;
            const float* mdn = MODN + (size_t)ms * 9216 + shoff + cb0;
#pragma unroll
            for (int bj = 0; bj < 2; ++bj) {
                const int co = bj * 128;
                const float4 gg0 = *(const float4*)(lng + cb0 + co), gg1 = *(const float4*)(lng + cb0 + co + 4);
                const float4 bb0 = *(const float4*)(lnb + cb0 + co), bb1 = *(const float4*)(lnb + cb0 + co + 4);
                float4 sh0 = make_float4(0.f, 0.f, 0.f, 0.f), sh1 = sh0, sc0 = sh0, sc1 = sh0;
                if (has_xm) { sh0 = *(const float4*)(mdn + co); sh1 = *(const float4*)(mdn + co + 4); sc0 = *(const float4*)(mdn + 1024 + co); sc1 = *(const float4*)(mdn + 1024 + co + 4); }
                size_t o = (size_t)(u.pm * 256 + wr * 64 + fr) * D + cb0 + co;
                int r = wr * 64 + fr;
                asm volatile("" : "+v"(o), "+v"(r));
#pragma unroll
                for (int ai = 0; ai < 2; ++ai) {
#pragma unroll
                    for (int m = 0; m < 4; ++m) {
                        const f32x2v sr = S[r];
                        const f32x4 a = acc[ai][bj][m][0], b = acc[ai][bj][m][1];
                        const float x0 = (a[0] - sr.x) * sr.y * gg0.x + bb0.x, x1 = (a[1] - sr.x) * sr.y * gg0.y + bb0.y;
                        const float x2 = (a[2] - sr.x) * sr.y * gg0.z + bb0.z, x3 = (a[3] - sr.x) * sr.y * gg0.w + bb0.w;
                        const float x4 = (b[0] - sr.x) * sr.y * gg1.x + bb1.x, x5 = (b[1] - sr.x) * sr.y * gg1.y + bb1.y;
                        const float x6 = (b[2] - sr.x) * sr.y * gg1.z + bb1.z, x7 = (b[3] - sr.x) * sr.y * gg1.w + bb1.w;
                        if (has_xm) {
                            *(uint4*)(X + o) = make_uint4(pack2(x0, x1), pack2(x2, x3), pack2(x4, x5), pack2(x6, x7));
                            *(uint4*)(XM + o) = make_uint4(pack2(x0 * (1.f + sc0.x) + sh0.x, x1 * (1.f + sc0.y) + sh0.y), pack2(x2 * (1.f + sc0.z) + sh0.z, x3 * (1.f + sc0.w) + sh0.w),
                                                           pack2(x4 * (1.f + sc1.x) + sh1.x, x5 * (1.f + sc1.y) + sh1.y), pack2(x6 * (1.f + sc1.z) + sh1.z, x7 * (1.f + sc1.w) + sh1.w));
                        } else {
                            *(float4*)(outp + o) = make_float4(x0, x1, x2, x3);
                            *(float4*)(outp + o + 4) = make_float4(x4, x5, x6, x7);
                        }
                        o += 16 * D; r += 16;
                        asm volatile("" : "+v"(o), "+v"(r) :: "memory");
                    }
                    o += 64 * D; r += 64;
                }
            }
        }
    }
};

__device__ __forceinline__ void convert_on_idle(const Params& p, int l, int part, unsigned char* smem) {
    const int bid = fresh_bid();
    if (l + 1 < 4 && bid >= 192) {
#pragma unroll 1
        for (int k = 0; k < 7; ++k) convert_tile(p, l + 1, part * 448 + (bid - 192) * 7 + k, smem);
    }
}
__device__ __forceinline__ void phase_ffn_up(const Params& p, int l, int i, unsigned char* smem) {
    pg8::Gemm g{(const u16*)(p.ws + OFF_XM), (const u16*)(p.ws + OFF_WGU + (size_t)(l & 1) * WSET) + (size_t)i * 5632 * 1024, 1024};
    pg8::Sched S; S.init(48, 22, (int)gridDim.x, fresh_bid(), 0);
    EpiSwiglu E{(u16*)(p.ws + OFF_U)};
    pg8::gemm_phase((LAS unsigned char*)smem, g, S, E);
}
__device__ __forceinline__ void phase_gemm_resid_ln(const Params& p, int l, const u16* A, const u16* W, int K, int goff, float gs, int lni, int ml, int shoff, bool final_, unsigned char* smem) {
    pg8::Gemm g{A, W, K};
    pg8::Sched S; S.init(48, 4, (int)gridDim.x, fresh_bid(), 0);
    const float* MOD = (const float*)(p.ws + OFF_MOD);
    EpiResidLn E{(u16*)(p.ws + OFF_X), p.out, (u16*)(p.ws + OFF_XM), MOD + (size_t)l * 5 * 9216, goff, gs,
                 p.in[11] + (size_t)(l * 3 + lni) * D, p.in[12] + (size_t)(l * 3 + lni) * D, MOD + (size_t)ml * 5 * 9216, shoff, final_ ? 0 : 1,
                 (unsigned long long*)(p.ws + OFF_XBUF), (unsigned*)(p.ws + OFF_LNCNT), 32u * (unsigned)(l * 3 + lni + 1)};
    pg8::gemm_phase((LAS unsigned char*)smem, g, S, E);
    convert_on_idle(p, l, lni == 0 ? 0 : (lni == 1 ? 2 : 3), smem);
}
__device__ __forceinline__ void phase_inproj(const Params& p, int l, unsigned char* smem) {
    pg8::Gemm g{(const u16*)(p.ws + OFF_XM), (const u16*)(p.ws + OFF_WIN + (size_t)(l & 1) * WSET), 1024};
    pg8::Sched S; S.init(48, 36, (int)gridDim.x, fresh_bid(), 0);
    EpiU E{(u16*)(p.ws + OFF_U), (const float*)(p.ws + OFF_LBS) + l * 1024};
    pg8::gemm_phase((LAS unsigned char*)smem, g, S, E);
}
__device__ __forceinline__ void phase_branch(const Params& p, int l, unsigned char* smem) {
    pg8::Gemm g{(const u16*)(p.ws + OFF_Y), (const u16*)(p.ws + OFF_WBR + (size_t)(l & 1) * WSET), 512};
    pg8::Sched S; S.init(48, 4, (int)gridDim.x, fresh_bid(), 1);
    EpiBranch E{(const u16*)(p.ws + OFF_U), (u16*)(p.ws + OFF_Z), (u16*)(p.ws + OFF_G)};
    pg8::gemm_phase((LAS unsigned char*)smem, g, S, E);
    convert_on_idle(p, l, 1, smem);
}

__device__ __forceinline__ float conv_xbc(const u16* U, int t0, int L, int pos, int c, float w0, float w1, float w2, float bias) {
    const u16* base = U + (size_t)t0 * DINP + MXBC + c;
    float m1 = bf2f(base[(size_t)pos * DINP]);
    float m0 = pos > 0 ? bf2f(base[(size_t)(pos - 1) * DINP]) : 0.f;
    float m2 = pos + 1 < L ? bf2f(base[(size_t)(pos + 1) * DINP]) : 0.f;
    return silu(w0 * m0 + w1 * m1 + w2 * m2 + bias);
}

#define WL128(j, v, coff) { const int ch_ = tid + (j) * 256, i_ = ch_ >> 4, cc_ = ch_ & 15; const int pos_ = dir ? (L - 1 - (cbase + i_)) : (cbase + i_); \
    v = *(const uint4*)(U + (size_t)(t0 + pos_) * DINP + (coff) + cc_ * 8); }
#define WS128(j, v, dst) { const int ch_ = tid + (j) * 256, i_ = ch_ >> 4, cc_ = ch_ & 15; *(uint4*)((dst) + i_ * 136 + cc_ * 8) = v; }
#define WL64(j, v, coff) { const int ch_ = tid + (j) * 256, i_ = ch_ >> 3, cc_ = ch_ & 7; const int pos_ = dir ? (L - 1 - (cbase + i_)) : (cbase + i_); \
    v = *(const uint4*)(U + (size_t)(t0 + pos_) * DINP + (coff) + cc_ * 8); }
#define WL64G(j, v, base, stride, coff) { const int ch_ = tid + (j) * 256, i_ = ch_ >> 3, cc_ = ch_ & 7; const int pos_ = dir ? (L - 1 - (cbase + i_)) : (cbase + i_); \
    v = *(const uint4*)((base) + (size_t)(t0 + pos_) * (stride) + (coff) + cc_ * 8); }
#define WS64(j, v, dst) { const int ch_ = tid + (j) * 256, i_ = ch_ >> 3, cc_ = ch_ & 7; *(uint4*)((dst) + i_ * 136 + cc_ * 8) = v; }
#define WST64(j, v) { const int ch_ = tid + (j) * 256, i_ = ch_ >> 3, cc_ = ch_ & 7; _Pragma("unroll") for (int e_ = 0; e_ < 8; ++e_) Vts[(cc_ * 8 + e_) * 72 + (i_ ^ (cc_ << 3))] = get16(v, e_); }

template <int MX>
__device__ __forceinline__ void scan_item(const Params& p, int l, int sq, int dir, int h, int vhalf, unsigned char* smem) {
    constexpr int DK = (MX == 2) ? 64 : 128;
    constexpr int NKT = DK / 32;
    const int tid = fresh_tid() & 255, lane = tid & 63, w = tid >> 6, wm = w >> 1, wn = w & 1, lr = lane & 15, lq = lane >> 4;
    u16* Qs = (u16*)smem;
    u16* Ks = Qs + 64 * 136;
    u16* Kts = Ks + 64 * 136;
    u16* Vts = Kts + 128 * 72;
    u16* Sts = Vts + 64 * 72;
    float* fa = (float*)(Sts + 64 * 136);
    u16* ATT = (MX == 2) ? (Kts + 64 * 72) : Ks;
    float* scal = (float*)(Vts + 64);
    float* rowv = fa, *colv = fa + 64, *rsv = fa + 128, *kwv = fa + 192;
    float* f256 = fa + 256, *f320 = fa + 320, *f384 = fa + 384;

    const bool lat = sq >= 32;
    const int bidx = lat ? sq - 32 : sq;
    const int t0 = lat ? TCTX + bidx * 1024 : sq * 256;
    const int L = lat ? 1024 : 256;
    const int nchunk = L >> 6;
    const u16* U = (const u16*)(p.ws + OFF_U);
    u16* O = (u16*)(p.ws + OFF_O) + (size_t)(MX * 2 + dir) * TT * 512;
    const int NH = (MX == 2) ? 8 : 4;
    const size_t sidx = ((size_t)(bidx * 4 + l) * 2 + dir) * NH + h;

    f32x4 S[2][NKT];
    if (lat) {
        if (MX == 2) {
            const float* sp = p.in[6] + sidx * 4096;
#pragma unroll
            for (int mi = 0; mi < 2; ++mi)
#pragma unroll
                for (int ni = 0; ni < NKT; ++ni)
#pragma unroll
                    for (int r = 0; r < 4; ++r) {
                        int v = wm * 32 + mi * 16 + lq * 4 + r, k = wn * (DK / 2) + ni * 16 + lr;
                        S[mi][ni][r] = sp[v * 64 + k];
                    }
        } else {
            const float* sp = (MX == 0 ? p.in[2] : p.in[3]) + sidx * 16384;
#pragma unroll
            for (int mi = 0; mi < 2; ++mi)
#pragma unroll
                for (int ni = 0; ni < NKT; ++ni) {
                    int v = vhalf * 64 + wm * 32 + mi * 16 + lq * 4, k = wn * (DK / 2) + ni * 16 + lr;
                    float4 t = *(const float4*)(sp + k * 128 + v);
                    S[mi][ni] = (f32x4){t.x, t.y, t.z, t.w};
                }
        }
    } else {
#pragma unroll
        for (int mi = 0; mi < 2; ++mi)
#pragma unroll
            for (int ni = 0; ni < NKT; ++ni) S[mi][ni] = (f32x4){0.f, 0.f, 0.f, 0.f};
    }
    float mcar = 0.f, gb_i = 0.f, gb_f = 0.f;
    if (MX == 1) {
        if (lat) mcar = p.in[5][sidx];
        gb_i = p.in[18][((l * 2 + 0) * 2 + dir) * 4 + h];
        gb_f = p.in[18][((l * 2 + 1) * 2 + dir) * 4 + h];
        if (tid < 128) f384[tid] = lat ? p.in[4][sidx * 128 + tid] : 0.f;
    }
    float dtb = 0.f, aexp = 0.f;
    if (MX == 2) {
        dtb = p.in[22][(l * 2 + dir) * 8 + h];
        aexp = expf(p.in[23][(l * 2 + dir) * 8 + h]);
    }
    if (MX != 0) {
#pragma unroll
        for (int mi = 0; mi < 2; ++mi)
#pragma unroll
            for (int ni = 0; ni < NKT; ++ni) {
                const int k = wn * (DK / 2) + ni * 16 + lr;
#pragma unroll
                for (int r = 0; r < 4; ++r) Sts[(wm * 32 + mi * 16 + lq * 4 + r) * 136 + k] = f2bf(S[mi][ni][r]);
            }
    }
    __syncthreads();

    unsigned sink = 0u;
    for (int c = 0; c < nchunk; ++c) {
        float a_dec = 1.f, m_next = 0.f;
        const int cbase = c * 64;
        if (MX == 0) {
            uint4 rf0, rf1, rf2, rf3, rq0, rq1, rq2, rq3, rv0, rv1;
            const int cf_ = HF + dir * 512 + h * 128, cq_ = HQ + h * 128, cv_ = HI + h * 128 + vhalf * 64;
            WL128(0, rf0, cf_) WL128(1, rf1, cf_) WL128(2, rf2, cf_) WL128(3, rf3, cf_)
            WL128(0, rq0, cq_) WL128(1, rq1, cq_) WL128(2, rq2, cq_) WL128(3, rq3, cq_)
            WL64(0, rv0, cv_) WL64(1, rv1, cv_)
            if (c + 1 < nchunk) {
                const int i_ = tid >> 2, q4 = tid & 3;
                const int posn = dir ? (L - 1 - (cbase + 64 + i_)) : (cbase + 64 + i_);
                const volatile u16* rowp = (const volatile u16*)(U + (size_t)(t0 + posn) * DINP);
                int c0, c1 = -1;
                if (MX == 0) {
                        c0 = (q4 < 2) ? (HF + dir * 512 + h * 128 + q4 * 64) : (HQ + h * 128 + (q4 - 2) * 64);
                        if (q4 == 0) c1 = HI + h * 128 + vhalf * 64;
                } else if (MX == 1) {
                        c0 = (q4 < 2) ? (MQ + h * 128 + q4 * 64) : (MK + h * 128 + (q4 - 2) * 64);
                        if (q4 == 0) c1 = MV + h * 128 + vhalf * 64;
                        if (q4 == 1) c1 = MI;
                } else {
                        const int g_ = h >> 2;
                        c0 = (q4 == 0) ? (MXBC + 640 + g_ * 64) : (q4 == 1) ? (MXBC + 512 + g_ * 64) : (q4 == 2) ? (MXBC + h * 64) : (MDT + dir * 8 + h);
                        if (q4 < 3) c1 = c0 + 63;
                }
                sink += rowp[c0];
                if (c1 >= 0) sink += rowp[c1];
            }
            WS128(0, rf0, Ks) WS128(1, rf1, Ks) WS128(2, rf2, Ks) WS128(3, rf3, Ks)
            WS128(0, rq0, Qs) WS128(1, rq1, Qs) WS128(2, rq2, Qs) WS128(3, rq3, Qs)
            WST64(0, rv0) WST64(1, rv1)
            __syncthreads();
            const int k = tid & 127, half = tid >> 7;
            float run = 0.f, run16 = 0.f;
#pragma unroll
            for (int j = 0; j < 32; ++j) { run += bf2f(Ks[(half * 32 + j) * 136 + k]); if (j == 15) run16 = run; }
            (half ? f384 : f256)[k] = run;
            fa[half * 128 + k] = run16;
            __syncthreads();
            const float t0v = f256[k], t1v = f384[k];
            const float e1 = __expf(t1v);
            const int g_ = vhalf, sub = half;
            const int ooff = g_ ? -81920 : 81920;
            u16* Qo = (u16*)((unsigned char*)Qs + ooff);
            u16* Ko = (u16*)((unsigned char*)Ks + ooff);
            u16* Kto = (u16*)((unsigned char*)Kts + ooff);
            float r = (g_ ? 0.f : -t0v) + (sub ? fa[g_ * 128 + k] : 0.f);
            float kt8[8];
#pragma unroll
            for (int j = 0; j < 16; ++j) {
                const int i = g_ * 32 + sub * 16 + j;
                const float lf = bf2f(Ks[i * 136 + k]);
                r += lf;
                const float kk = 1.f - __expf(lf);
                const float er = __expf(fminf(fmaxf(r, -80.f), 80.f)), ier = __builtin_amdgcn_rcpf(er);
                const float q = bf2f(Qs[i * 136 + k]);
                const u16 qv = f2bf(q * er), kv = f2bf(kk * ier);
                Qs[i * 136 + k] = qv; Qo[i * 136 + k] = qv;
                Ks[i * 136 + k] = kv; Ko[i * 136 + k] = kv;
                kt8[j & 7] = kk * ier * e1;
                if ((j & 7) == 7) {
                    const uint4 pk = make_uint4(pack2(kt8[0], kt8[1]), pack2(kt8[2], kt8[3]), pack2(kt8[4], kt8[5]), pack2(kt8[6], kt8[7]));
                    *(uint4*)(Kts + k * 72 + (i - 7)) = pk;
                    *(uint4*)(Kto + k * 72 + (i - 7)) = pk;
                }
            }
        } else if (MX == 1) {
            uint4 rq0, rq1, rq2, rq3, rk0, rk1, rk2, rk3, rv0, rv1;
            float g_i = 0.f, g_f = 0.f;
            if (w == 0) {
                const int pos = dir ? (L - 1 - (cbase + lane)) : (cbase + lane);
                const u16* rowp = U + (size_t)(t0 + pos) * DINP;
                g_i = bf2f(rowp[MI + dir * 4 + h]);
                g_f = bf2f(rowp[MF + dir * 4 + h]);
            }
            const int cq_ = MQ + h * 128, ck_ = MK + h * 128, cv_ = MV + h * 128 + vhalf * 64;
            WL128(0, rq0, cq_) WL128(1, rq1, cq_) WL128(2, rq2, cq_) WL128(3, rq3, cq_)
            WL128(0, rk0, ck_) WL128(1, rk1, ck_) WL128(2, rk2, ck_) WL128(3, rk3, ck_)
            WL64(0, rv0, cv_) WL64(1, rv1, cv_)
        if (c + 1 < nchunk) {
            const int i_ = tid >> 2, q4 = tid & 3;
            const int posn = dir ? (L - 1 - (cbase + 64 + i_)) : (cbase + 64 + i_);
            const volatile u16* rowp = (const volatile u16*)(U + (size_t)(t0 + posn) * DINP);
            int c0, c1 = -1;
            if (MX == 0) {
                c0 = (q4 < 2) ? (HF + dir * 512 + h * 128 + q4 * 64) : (HQ + h * 128 + (q4 - 2) * 64);
                if (q4 == 0) c1 = HI + h * 128 + vhalf * 64;
            } else if (MX == 1) {
                c0 = (q4 < 2) ? (MQ + h * 128 + q4 * 64) : (MK + h * 128 + (q4 - 2) * 64);
                if (q4 == 0) c1 = MV + h * 128 + vhalf * 64;
                if (q4 == 1) c1 = MI;
            } else {
                const int g_ = h >> 2;
                c0 = (q4 == 0) ? (MXBC + 640 + g_ * 64) : (q4 == 1) ? (MXBC + 512 + g_ * 64) : (q4 == 2) ? (MXBC + h * 64) : (MDT + dir * 8 + h);
                if (q4 < 3) c1 = c0 + 63;
            }
            sink += rowp[c0];
            if (c1 >= 0) sink += rowp[c1];
        }
            if (w == 0) {
                const int i = lane;
                float ig = g_i + gb_i;
                float xf = g_f + gb_f;
                float b = -__logf(1.f + __expf(-xf));
#pragma unroll
                for (int o = 1; o < 64; o <<= 1) { float t = __shfl_up(b, o); if (lane >= o) b += t; }
                float u = ig - b;
                float pm = u;
#pragma unroll
                for (int o = 1; o < 64; o <<= 1) { float t = __shfl_up(pm, o); if (lane >= o) pm = fmaxf(pm, t); }
                float blast = __shfl(b, 63), pmlast = __shfl(pm, 63);
                float gmax = blast + pmlast;
                float mnew = fmaxf(blast + mcar, gmax);
                float mt = b + fmaxf(mcar, pm);
                rowv[i] = b - mt; colv[i] = u - 2.4260151319598084f; rsv[i] = __expf(b + mcar - mt);
                kwv[i] = __expf(blast + u - mnew) * 0.08838834764831845f; f256[i] = __expf(-mt);
                if (lane == 0) { scal[0] = __expf(blast + mcar - mnew); scal[1] = mnew; }
            }
            WS128(0, rq0, Qs) WS128(1, rq1, Qs) WS128(2, rq2, Qs) WS128(3, rq3, Qs)
            WS128(0, rk0, Ks) WS128(1, rk1, Ks) WS128(2, rk2, Ks) WS128(3, rk3, Ks)
            WST64(0, rv0) WST64(1, rv1)
            __syncthreads();
            a_dec = scal[0]; m_next = scal[1];
            {
                const int k = tid & 127, half = tid >> 7;
#pragma unroll
                for (int j8 = 0; j8 < 4; ++j8) {
                    const int i0 = half * 32 + j8 * 8;
                    float kt8[8];
#pragma unroll
                    for (int e = 0; e < 8; ++e) kt8[e] = bf2f(Ks[(i0 + e) * 136 + k]) * kwv[i0 + e];
                    *(uint4*)(Kts + k * 72 + i0) = make_uint4(pack2(kt8[0], kt8[1]), pack2(kt8[2], kt8[3]), pack2(kt8[4], kt8[5]), pack2(kt8[6], kt8[7]));
                }
            }
        } else {
            const int g = h >> 2;
            const u16* XBC = (const u16*)(p.ws + OFF_Z);
            float g_dt = 0.f;
            if (w == 0) {
                const int pos = dir ? (L - 1 - (cbase + lane)) : (cbase + lane);
                g_dt = bf2f(U[(size_t)(t0 + pos) * DINP + MDT + dir * 8 + h]);
            }
            uint4 rc0, rc1, rb0, rb1, rx0, rx1;
            WL64G(0, rc0, XBC, 768, 640 + g * 64) WL64G(1, rc1, XBC, 768, 640 + g * 64)
            WL64G(0, rb0, XBC, 768, 512 + g * 64) WL64G(1, rb1, XBC, 768, 512 + g * 64)
            WL64G(0, rx0, XBC, 768, h * 64) WL64G(1, rx1, XBC, 768, h * 64)
            if (c + 1 < nchunk) {
                const int i_ = tid >> 2, q4 = tid & 3;
                const int posn = dir ? (L - 1 - (cbase + 64 + i_)) : (cbase + 64 + i_);
                const volatile u16* xr_ = (const volatile u16*)(XBC + (size_t)(t0 + posn) * 768);
                const volatile u16* ur_ = (const volatile u16*)(U + (size_t)(t0 + posn) * DINP);
                if (q4 == 0) sink += xr_[640 + g * 64];
                else if (q4 == 1) sink += xr_[512 + g * 64];
                else if (q4 == 2) sink += xr_[h * 64];
                else sink += ur_[MDT + dir * 8 + h];
            }
            if (w == 0) {
                const int i = lane;
                float dt = g_dt + dtb;
                dt = (dt > 20.f) ? dt : __logf(1.f + __expf(dt));
                float a = -dt * aexp;
#pragma unroll
                for (int o = 1; o < 64; o <<= 1) { float t = __shfl_up(a, o); if (lane >= o) a += t; }
                float alast = __shfl(a, 63);
                rowv[i] = a; colv[i] = -a; rsv[i] = __expf(a); kwv[i] = __expf(alast - a); f256[i] = dt;
                if (lane == 0) { scal[0] = __expf(alast); scal[1] = 0.f; }
            }
            WS64(0, rc0, Qs) WS64(1, rc1, Qs)
            WS64(0, rb0, Ks) WS64(1, rb1, Ks)
            __syncthreads();
            a_dec = scal[0];
            {
#pragma unroll
                for (int j = 0; j < 2; ++j) {
                    const int ch_ = tid + j * 256, i_ = ch_ >> 3, cc_ = ch_ & 7;
                    const float dti = f256[i_];
                    const uint4 xv = j ? rx1 : rx0;
#pragma unroll
                    for (int e = 0; e < 8; ++e) Vts[(cc_ * 8 + e) * 72 + (i_ ^ (cc_ << 3))] = f2bf(bf2f(get16(xv, e)) * dti);
                }
                const int ch = tid & 63, grp = tid >> 6;
#pragma unroll
                for (int j8 = 0; j8 < 2; ++j8) {
                    const int i0 = grp * 16 + j8 * 8;
                    float kt8[8];
#pragma unroll
                    for (int e = 0; e < 8; ++e) kt8[e] = bf2f(Ks[(i0 + e) * 136 + ch]) * kwv[i0 + e];
                    *(uint4*)(Kts + ch * 72 + i0) = make_uint4(pack2(kt8[0], kt8[1]), pack2(kt8[2], kt8[3]), pack2(kt8[4], kt8[5]), pack2(kt8[6], kt8[7]));
                }
            }
        }
        __syncthreads();
        const bool s_zero = (!lat) && (c == 0);
        if (MX == 0 && !s_zero) {
#pragma unroll
            for (int mi = 0; mi < 2; ++mi)
#pragma unroll
                for (int ni = 0; ni < NKT; ++ni) {
                    const int k = wn * (DK / 2) + ni * 16 + lr;
                    const float sc = __expf(f256[k]);
#pragma unroll
                    for (int r = 0; r < 4; ++r) {
                        const int v = wm * 32 + mi * 16 + lq * 4 + r;
                        Sts[v * 136 + k] = f2bf(S[mi][ni][r] * sc);
                    }
                }
            __syncthreads();
        }
        if (MX == 1) {
            const int t = tid >> 2, part = tid & 3;
            float sacc = 0.f;
#pragma unroll
            for (int j = 0; j < 4; ++j) {
                const uint4 qv = *(const uint4*)(Qs + t * 136 + part * 32 + j * 8);
#pragma unroll
                for (int e = 0; e < 8; ++e) sacc += bf2f(get16(qv, e)) * f384[part * 32 + j * 8 + e];
            }
            sacc += __shfl_xor(sacc, 1); sacc += __shfl_xor(sacc, 2);
            if (part == 0) f320[t] = sacc;
        }
        f32x4 att[2][2], o[2][2];
#pragma unroll
        for (int a = 0; a < 2; ++a)
#pragma unroll
            for (int b = 0; b < 2; ++b) { att[a][b] = (f32x4){0.f, 0.f, 0.f, 0.f}; o[a][b] = (f32x4){0.f, 0.f, 0.f, 0.f}; }
        mma_nt<2, 2>(att, Qs + (wm * 32) * 136, 136, Ks + (wn * 32) * 136, 136, DK, lane);
        if (!s_zero) mma_nt<2, 2>(o, Qs + (wm * 32) * 136, 136, Sts + (wn * 32) * 136, 136, DK, lane);
        if (MX != 0) {
#pragma unroll
            for (int mi = 0; mi < 2; ++mi)
#pragma unroll
                for (int r = 0; r < 4; ++r) {
                    const float sc = rsv[wm * 32 + mi * 16 + lq * 4 + r];
#pragma unroll
                    for (int ni = 0; ni < 2; ++ni) o[mi][ni][r] *= sc;
                }
        }
        if (MX != 2) __syncthreads();
#pragma unroll
        for (int mi = 0; mi < 2; ++mi)
#pragma unroll
            for (int ni = 0; ni < 2; ++ni)
#pragma unroll
                for (int r = 0; r < 4; ++r) {
                    const int t = wm * 32 + mi * 16 + lq * 4 + r, s = wn * 32 + ni * 16 + lr;
                    float val = 0.f;
                    if (s <= t) {
                        val = att[mi][ni][r];
                        if (MX != 0) val *= __expf(rowv[t] + colv[s]);
                    }
                    ATT[t * 72 + s] = f2bf(val);
                }
        __syncthreads();
        mma_nt<2, 2, false, true>(o, ATT + (wm * 32) * 72, 72, Vts + (wn * 32) * 72, 72, 64, lane, 0, wn * 32);
        __builtin_amdgcn_sched_barrier(0);
        if (MX == 1) {
            {
                const int t = tid >> 2, part = tid & 3;
                float sacc = 0.f;
#pragma unroll
                for (int j = 0; j < 2; ++j) {
                    const uint4 av = *(const uint4*)(ATT + t * 72 + part * 16 + j * 8);
#pragma unroll
                    for (int e = 0; e < 8; ++e) sacc += bf2f(get16(av, e));
                }
                sacc += __shfl_xor(sacc, 1); sacc += __shfl_xor(sacc, 2);
                if (part == 0) {
                    float den = sacc + rsv[t] * f320[t];
                    f320[t] = fmaxf(fabsf(den), f256[t]);
                }
            }
        }
        __builtin_amdgcn_sched_barrier(0);
        {
            f32x4 Sn[2][NKT];
#pragma unroll
            for (int mi = 0; mi < 2; ++mi)
#pragma unroll
                for (int ni = 0; ni < NKT; ++ni) Sn[mi][ni] = (f32x4){0.f, 0.f, 0.f, 0.f};
            mma_nt<2, NKT, true, false>(Sn, Vts + (wm * 32) * 72, 72, Kts + (wn * (DK / 2)) * 72, 72, 64, lane, wm * 32, 0);
#pragma unroll
            for (int mi = 0; mi < 2; ++mi)
#pragma unroll
                for (int ni = 0; ni < NKT; ++ni) {
                    const int k = wn * (DK / 2) + ni * 16 + lr;
                    const float dec = (MX == 0) ? __expf(f256[k] + f384[k]) : a_dec;
#pragma unroll
                    for (int r = 0; r < 4; ++r) S[mi][ni][r] = dec * S[mi][ni][r] + Sn[mi][ni][r];
                }
        }
        if (MX != 0) {
#pragma unroll
            for (int mi = 0; mi < 2; ++mi)
#pragma unroll
                for (int ni = 0; ni < NKT; ++ni) {
                    const int k = wn * (DK / 2) + ni * 16 + lr;
#pragma unroll
                    for (int r = 0; r < 4; ++r) Sts[(wm * 32 + mi * 16 + lq * 4 + r) * 136 + k] = f2bf(S[mi][ni][r]);
                }
        }
        __builtin_amdgcn_sched_barrier(0);
        if (MX == 1) {
            {
                const int k = tid >> 1, part = tid & 1;
                float sacc = 0.f;
#pragma unroll
                for (int j = 0; j < 4; ++j) {
                    const uint4 kv = *(const uint4*)(Kts + k * 72 + part * 32 + j * 8);
#pragma unroll
                    for (int e = 0; e < 8; ++e) sacc += bf2f(get16(kv, e));
                }
                sacc += __shfl_xor(sacc, 1);
                if (part == 0) f384[k] = a_dec * f384[k] + sacc;
            }
            __syncthreads();
        }
#pragma unroll
        for (int mi = 0; mi < 2; ++mi)
#pragma unroll
            for (int r = 0; r < 4; ++r) {
                const int t = wm * 32 + mi * 16 + lq * 4 + r;
                const int pos = dir ? (L - 1 - (c * 64 + t)) : (c * 64 + t);
                const float inv = (MX == 1) ? 1.f / f320[t] : 1.f;
#pragma unroll
                for (int ni = 0; ni < 2; ++ni) {
                    const int v = wn * 32 + ni * 16 + lr;
                    const int col = (MX == 2) ? (h * 64 + v) : (h * 128 + vhalf * 64 + v);
                    O[(size_t)(t0 + pos) * 512 + col] = f2bf(o[mi][ni][r] * inv);
                }
            }
        if (MX == 1) mcar = m_next;
        __syncthreads();
    }
    if (sink == 0x7fffdeadu) ((volatile unsigned*)(p.ws + OFF_CTR))[60] = sink;
    if (!lat) {
        const int o0 = TT * D;
        if (MX == 0 || MX == 1) {
            float* dst = p.out + o0 + (MX == 0 ? 0 : 16777216) + sidx * 16384;
#pragma unroll
            for (int mi = 0; mi < 2; ++mi)
#pragma unroll
                for (int ni = 0; ni < NKT; ++ni) {
                    int v = vhalf * 64 + wm * 32 + mi * 16 + lq * 4, k = wn * (DK / 2) + ni * 16 + lr;
                    *(float4*)(dst + k * 128 + v) = make_float4(S[mi][ni][0], S[mi][ni][1], S[mi][ni][2], S[mi][ni][3]);
                }
            if (MX == 1 && vhalf == 0) {
                if (tid < 128) p.out[o0 + 2 * 16777216 + sidx * 128 + tid] = f384[tid];
                if (tid == 0) p.out[o0 + 2 * 16777216 + 131072 + sidx] = mcar;
            }
        } else {
            float* dst = p.out + o0 + 2 * 16777216 + 131072 + 1024 + sidx * 4096;
#pragma unroll
            for (int mi = 0; mi < 2; ++mi)
#pragma unroll
                for (int ni = 0; ni < NKT; ++ni)
#pragma unroll
                    for (int r = 0; r < 4; ++r) {
                        int v = wm * 32 + mi * 16 + lq * 4 + r, k = wn * (DK / 2) + ni * 16 + lr;
                        dst[v * 64 + k] = S[mi][ni][r];
                    }
        }
    }
    __syncthreads();
}

__device__ __forceinline__ void phase_scan(const Params& p, int l, unsigned char* smem) {
    int* ctr = (int*)(p.ws + OFF_CTR) + l;
    int* qslot = (int*)((u16*)smem + 2 * 64 * 136 + 128 * 72 + 72 + 64);
    const int grp = fresh_tid() >> 8;
    unsigned char* gsm = smem + grp * 81920;
    for (;;) {
        if (fresh_tid() == 0) *qslot = atomicAdd(ctr, 1);
        __syncthreads();
        const int pr = *qslot;
        __syncthreads();
        if (pr >= 864) break;
        const int idx = 2 * pr + grp;
        int mx, sq, r2;
        if (idx < 192) { mx = idx / 64; int r = idx % 64; sq = 32 + r / 16; r2 = r % 16; }
        else { int j = idx - 192; mx = j / 512; int r = j % 512; sq = r / 16; r2 = r % 16; }
        const int dir = r2 >> 3;
        if (mx == 0) scan_item<0>(p, l, sq, dir, (r2 >> 1) & 3, r2 & 1, gsm);
        else if (mx == 1) scan_item<1>(p, l, sq, dir, (r2 >> 1) & 3, r2 & 1, gsm);
        else scan_item<2>(p, l, sq, dir, r2 & 7, 0, gsm);
    }
}

__device__ __forceinline__ void phase_conv(const Params& p, int l) {
    const u16* U = (const u16*)(p.ws + OFF_U);
    u16* XBC = (u16*)(p.ws + OFF_Z);
    const float* cw = p.in[20] + (size_t)l * 3 * 768;
    const float* cb = p.in[21] + (size_t)l * 768;
    const int tid = fresh_tid();
    const int cstride = gridDim.x * NTHR;
    for (int task0 = fresh_bid() * NTHR + tid; task0 < TT * 96; task0 += 2 * cstride) {
        uint4 x0[2], x1[2], x2[2]; int tokv[2], c0v[2]; bool okv[2];
#pragma unroll
        for (int r = 0; r < 2; ++r) {
            const int task = task0 + r * cstride;
            okv[r] = task < TT * 96;
            const int tk = okv[r] ? task : task0;
            const int tok = tk / 96, c0 = (tk - tok * 96) * 8;
            tokv[r] = tok; c0v[r] = c0;
            int L, pos;
            if (tok < TCTX) { L = 256; pos = tok & 255; } else { L = 1024; pos = (tok - TCTX) & 1023; }
            const u16* ur = U + (size_t)tok * DINP + MXBC + c0;
            x1[r] = *(const uint4*)ur;
            x0[r] = make_uint4(0, 0, 0, 0); x2[r] = make_uint4(0, 0, 0, 0);
            if (pos > 0) x0[r] = *(const uint4*)(ur - DINP);
            if (pos + 1 < L) x2[r] = *(const uint4*)(ur + DINP);
        }
#pragma unroll
        for (int r = 0; r < 2; ++r) {
            if (!okv[r]) continue;
            const int c0 = c0v[r];
            float y[8];
#pragma unroll
            for (int j = 0; j < 8; ++j) {
                const int c = c0 + j;
                y[j] = silu(cw[c] * bf2f(get16(x0[r], j)) + cw[768 + c] * bf2f(get16(x1[r], j)) + cw[1536 + c] * bf2f(get16(x2[r], j)) + cb[c]);
            }
            *(uint4*)(XBC + (size_t)tokv[r] * 768 + c0) = make_uint4(pack2(y[0], y[1]), pack2(y[2], y[3]), pack2(y[4], y[5]), pack2(y[6], y[7]));
        }
    }
}

struct PostIn { uint4 a0f, a0b, a1f, a1b, a2f, a2b, g0, g1, g2, xcv; };
__device__ __forceinline__ PostIn post_load(const u16* U, const u16* O, const u16* XBC, int tok, int c0) {
    PostIn q;
    const u16* ur = U + (size_t)tok * DINP;
    q.a0f = *(const uint4*)(O + ((size_t)0 * TT + tok) * 512 + c0); q.a0b = *(const uint4*)(O + ((size_t)1 * TT + tok) * 512 + c0);
    q.a1f = *(const uint4*)(O + ((size_t)2 * TT + tok) * 512 + c0); q.a1b = *(const uint4*)(O + ((size_t)3 * TT + tok) * 512 + c0);
    q.a2f = *(const uint4*)(O + ((size_t)4 * TT + tok) * 512 + c0); q.a2b = *(const uint4*)(O + ((size_t)5 * TT + tok) * 512 + c0);
    q.g0 = *(const uint4*)(ur + HGO + c0); q.g1 = *(const uint4*)(ur + MO + c0); q.g2 = *(const uint4*)(ur + MZ + c0);
    q.xcv = *(const uint4*)(XBC + (size_t)tok * 768 + c0);
    return q;
}
__device__ __forceinline__ void post_compute(const Params& p, int l, const PostIn& q, u16* Y, int tok, int c0) {
#pragma unroll
    for (int mx = 0; mx < 2; ++mx) {
        const uint4 af = mx ? q.a1f : q.a0f, ab = mx ? q.a1b : q.a0b, gt = mx ? q.g1 : q.g0;
        float ov[8]; float ss = 0.f;
#pragma unroll
        for (int j = 0; j < 8; ++j) { ov[j] = bf2f(get16(af, j)) + bf2f(get16(ab, j)); ss += ov[j] * ov[j]; }
#pragma unroll
        for (int o = 8; o >= 1; o >>= 1) ss += __shfl_xor(ss, o);
        const float rs = rsqrtf(ss * (1.f / 128.f) + 1e-6f);
        const float* ng = (mx == 0 ? p.in[17] : p.in[19]) + (size_t)l * 512 + c0;
        float y[8];
#pragma unroll
        for (int j = 0; j < 8; ++j) {
            float gv = bf2f(get16(gt, j));
            y[j] = ov[j] * rs * ng[j] * (mx == 0 ? silu(gv) : sigm(gv));
        }
        *(uint4*)(Y + ((size_t)mx * TT + tok) * 512 + c0) = make_uint4(pack2(y[0], y[1]), pack2(y[2], y[3]), pack2(y[4], y[5]), pack2(y[6], y[7]));
    }
    {
        const float dsk = p.in[24][l * 8 + (c0 >> 6)];
        float z[8]; float ss = 0.f;
#pragma unroll
        for (int j = 0; j < 8; ++j) {
            float xc = bf2f(get16(q.xcv, j));
            float yv = bf2f(get16(q.a2f, j)) + bf2f(get16(q.a2b, j)) + dsk * xc;
            z[j] = yv * silu(bf2f(get16(q.g2, j)));
            ss += z[j] * z[j];
        }
#pragma unroll
        for (int o = 32; o >= 1; o >>= 1) ss += __shfl_xor(ss, o);
        const float rs = rsqrtf(ss * (1.f / 512.f) + 1e-6f);
        const float* ng = p.in[25] + (size_t)l * 512 + c0;
        float y[8];
#pragma unroll
        for (int j = 0; j < 8; ++j) y[j] = z[j] * rs * ng[j];
        *(uint4*)(Y + ((size_t)2 * TT + tok) * 512 + c0) = make_uint4(pack2(y[0], y[1]), pack2(y[2], y[3]), pack2(y[4], y[5]), pack2(y[6], y[7]));
    }
}
__device__ __forceinline__ void phase_post(const Params& p, int l) {
    const u16* U = (const u16*)(p.ws + OFF_U);
    const u16* O = (const u16*)(p.ws + OFF_O);
    const u16* XBC = (const u16*)(p.ws + OFF_Z);
    u16* Y = (u16*)(p.ws + OFF_Y);
    const int tid_ = fresh_tid(); const int lane = tid_ & 63, w = tid_ >> 6;
    const int c0 = lane * 8;
    const int stride = gridDim.x * NW;
    for (int tok = fresh_bid() * NW + w; tok < TT; tok += 2 * stride) {
        const int tok2 = tok + stride;
        const bool has2 = tok2 < TT;
        const PostIn qa = post_load(U, O, XBC, tok, c0);
        const PostIn qb = post_load(U, O, XBC, has2 ? tok2 : tok, c0);
        post_compute(p, l, qa, Y, tok, c0);
        if (has2) post_compute(p, l, qb, Y, tok2, c0);
    }
}

__global__ void __launch_bounds__(NTHR, 2) fwd_megakernel(Params p0) {
    extern __shared__ __attribute__((aligned(16))) unsigned char smem[];
    cg::grid_group grid = cg::this_grid();
    volatile LAS unsigned* bst = (volatile LAS unsigned*)((LAS unsigned char*)smem + 81920 + 53248 + 2 * 144 + 128);
    if (threadIdx.x == 0) { bst[0] = 0u; bst[1] = 0u; }
    __syncthreads();
    { Params q = fresh(p0); (void)xcd_barrier_post((unsigned*)(q.ws + OFF_BAR), bst); }
    { Params p = fresh(p0); phase_mod(p, smem); }
    __syncthreads();
    { Params p = fresh(p0); convert_layer(p, 0, smem); }
    grid.sync();
    { Params p = fresh(p0); phase_xinit(p); }
    xcd_barrier(p0, smem);
#pragma unroll 1
    for (int l = 0; l < 4; ++l) {
        { Params p = fresh(p0); phase_ffn_up(p, l, 0, smem); }
        xcd_barrier(p0, smem);
        { Params p = fresh(p0); phase_gemm_resid_ln(p, l, (const u16*)(p.ws + OFF_U), (const u16*)(p.ws + OFF_WDN + (size_t)(l & 1) * WSET), DFF, 2048, 0.5f, 0, l, 3072, false, smem); }
        xcd_barrier(p0, smem);
        { Params p = fresh(p0); phase_inproj(p, l, smem); }
        xcd_barrier(p0, smem);
        { Params p = fresh(p0); phase_conv(p, l); }
        xcd_barrier(p0, smem);
        { Params p = fresh(p0); phase_scan(p, l, smem); }
        xcd_barrier(p0, smem);
        { Params p = fresh(p0); phase_post(p, l); }
        xcd_barrier(p0, smem);
        { Params p = fresh(p0); phase_branch(p, l, smem); }
        xcd_barrier(p0, smem);
        { Params p = fresh(p0); phase_gemm_resid_ln(p, l, (const u16*)(p.ws + OFF_G), (const u16*)(p.ws + OFF_WOUT + (size_t)(l & 1) * WSET), D, 5120, 1.0f, 1, l, 6144, false, smem); }
        xcd_barrier(p0, smem);
        { Params p = fresh(p0); phase_ffn_up(p, l, 1, smem); }
        xcd_barrier(p0, smem);
        { Params p = fresh(p0); phase_gemm_resid_ln(p, l, (const u16*)(p.ws + OFF_U), (const u16*)(p.ws + OFF_WDN + (size_t)(l & 1) * WSET) + (size_t)1024 * 2816, DFF, 8192, 0.5f, 2, l + 1 < 4 ? l + 1 : l, 0, l == 3, smem); }
        if (l + 1 < 4) xcd_barrier(p0, smem);
    }
}

extern "C" void kernel_launch(void* const* d_in, const int* in_sizes, int n_in, void* d_out, int out_size, void* d_ws,
                              size_t ws_size, hipStream_t stream) {
    static int grid_blocks = 0;
    if (!grid_blocks) {
        int dev = 0, cus = 0, per_cu = 0;
        hipGetDevice(&dev);
        hipDeviceGetAttribute(&cus, hipDeviceAttributeMultiprocessorCount, dev);
        hipFuncSetAttribute((const void*)fwd_megakernel, hipFuncAttributeMaxDynamicSharedMemorySize, LDS_BYTES);
        hipOccupancyMaxActiveBlocksPerMultiprocessor(&per_cu, (const void*)fwd_megakernel, NTHR, LDS_BYTES);
        if (per_cu < 1) per_cu = 1;
        if (per_cu > 1) per_cu = 1;
        grid_blocks = cus * per_cu;
        if (ws_size < WS_END) fprintf(stderr, "workspace too small: %zu < %zu\n", ws_size, (size_t)WS_END);
    }
    Params p{};
    for (int i = 0; i < 28 && i < n_in; ++i) p.in[i] = (const float*)d_in[i];
    p.out = (float*)d_out;
    p.ws = (unsigned char*)d_ws;
    hipMemsetAsync((char*)d_ws + OFF_CTR, 0, CTL_BYTES, stream);
    void* args[] = {&p};
    hipError_t e = hipLaunchCooperativeKernel((const void*)fwd_megakernel, dim3(grid_blocks), dim3(NTHR), args, LDS_BYTES, stream);
    if (e != hipSuccess) fprintf(stderr, "cooperative launch failed: %s (grid %d)\n", hipGetErrorString(e), grid_blocks);
}
```
